# Optimizing an MI355X kernel written in HIP

```python
import jax, jax.numpy as jnp
from jax import lax
import numpy as np

D_MODEL = 4096
BATCH = 2
SEQ = 8192
DEPTH = 1

RWKV_HEAD_DIM = 64
D_RWKV = D_MODEL // 2
RWKV_HEADS = D_RWKV // RWKV_HEAD_DIM
LORA_DECAY = 96
LORA_ICLR = 96
LORA_GATE = 256
D_CONV = D_MODEL // 2
CONV_WIDTH = 3
D_FF = 11008
NORM_EPS = 1e-6
LNX_EPS = 64e-5
N_ADA = 6
N_SHIFT = 3 * D_RWKV + LORA_DECAY + LORA_ICLR + LORA_GATE
N_IN = N_SHIFT + 3 * D_CONV + 2 * D_MODEL

kernel_name = "hybrid_rwkv7_shortconv_convffn_adaln"


def rmsnorm(x, gain):
    xf = x.astype(jnp.float32)
    y = xf * lax.rsqrt(jnp.mean(xf * xf, axis=-1, keepdims=True) + NORM_EPS)
    return (y * gain.astype(jnp.float32)).astype(x.dtype)


def modulate(h, shift, scale):
    return h * (1.0 + scale[:, None, :]) + shift[:, None, :]


def causal_dwconv(x, w):
    seq = x.shape[1]
    xp = jnp.pad(x, ((0, 0), (CONV_WIDTH - 1, 0), (0, 0)))
    return sum(xp[:, k:k + seq, :] * w[k] for k in range(CONV_WIDTH))


def token_shift(p, mu):
    prev = jnp.pad(p, ((0, 0), (1, 0), (0, 0)))[:, :-1, :]
    return p + (prev - p) * mu


def rwkv7_scan(r, decay, k, v, a, b):
    bsz, _, h, n = r.shape

    def step(S, inp):
        r_t, w_t, k_t, v_t, a_t, b_t = inp
        sa = jnp.einsum('bhij,bhj->bhi', S, a_t)
        S = (S * w_t[:, :, None, :] + sa[..., None] * b_t[:, :, None, :]
             + v_t[..., None] * k_t[:, :, None, :])
        return S, jnp.einsum('bhij,bhj->bhi', S, r_t)

    xs = tuple(jnp.moveaxis(t, 1, 0) for t in (r, decay, k, v, a, b))
    S0 = jnp.zeros((bsz, h, n, n), jnp.float32)
    _, ys = lax.scan(step, S0, xs)
    return jnp.moveaxis(ys, 0, 1)


def rwkv7_time_mix(p_r, p_k, p_v, p_wd, p_ad, p_gd, w0, a0, k_k, k_a, r_k,
                   w_lora_decay, w_lora_iclr, w_lora_gate, lnx_w, lnx_b):
    f32 = jnp.float32
    bsz, seq, _ = p_r.shape

    def heads(t):
        return t.astype(f32).reshape(bsz, seq, RWKV_HEADS, RWKV_HEAD_DIM)

    w_log = -jax.nn.softplus(-(w0 + jnp.tanh(p_wd) @ w_lora_decay).astype(f32)) - 0.5
    decay = jnp.exp(-jnp.exp(w_log))
    iclr = jax.nn.sigmoid((a0 + p_ad @ w_lora_iclr).astype(f32))
    g = (jax.nn.sigmoid(p_gd) @ w_lora_gate).astype(f32)
    kk = heads(p_k * k_k)
    kk = kk / jnp.maximum(jnp.sqrt(jnp.sum(kk * kk, axis=-1, keepdims=True)), 1e-12)
    k = p_k.astype(f32) * (1.0 + (iclr - 1.0) * k_a.astype(f32))
    r_h, k_h, v_h = heads(p_r), heads(k), heads(p_v)
    y = rwkv7_scan(r_h, heads(decay), k_h, v_h, -kk, kk * heads(iclr))
    mean = jnp.mean(y, axis=-1, keepdims=True)
    var = jnp.mean(jnp.square(y - mean), axis=-1, keepdims=True)
    y = ((y - mean) * lax.rsqrt(var + LNX_EPS)).reshape(bsz, seq, D_RWKV)
    y = y * lnx_w.astype(f32) + lnx_b.astype(f32)
    bonus = jnp.sum(r_h * k_h * r_k.astype(f32), axis=-1, keepdims=True) * v_h
    o = (y + bonus.reshape(bsz, seq, D_RWKV)) * g
    return o.astype(p_r.dtype)


def token_mixer(h, w_in, mu_shift, w0, a0, k_k, k_a, r_k, w_lora_decay, w_lora_iclr,
                w_lora_gate, lnx_w, lnx_b, conv_w_mix, w_o_rwkv, w_o_conv, w_out):
    proj = h @ w_in
    p_shift = token_shift(proj[..., :N_SHIFT], mu_shift)
    p_conv = proj[..., N_SHIFT:N_SHIFT + 3 * D_CONV]
    p_gate = proj[..., N_SHIFT + 3 * D_CONV:]
    cuts = np.cumsum([D_RWKV, D_RWKV, D_RWKV, LORA_DECAY, LORA_ICLR]).tolist()
    p_r, p_k, p_v, p_wd, p_ad, p_gd = jnp.split(p_shift, cuts, axis=-1)
    y_a = rwkv7_time_mix(p_r, p_k, p_v, p_wd, p_ad, p_gd, w0, a0, k_k, k_a, r_k,
                         w_lora_decay, w_lora_iclr, w_lora_gate, lnx_w, lnx_b) @ w_o_rwkv
    c_b, c_c, c_x = jnp.split(p_conv, 3, axis=-1)
    y_b = (c_b * causal_dwconv(c_c * c_x, conv_w_mix)) @ w_o_conv
    g_a, g_b = jnp.split(p_gate, 2, axis=-1)
    merged = jax.nn.sigmoid(g_a) * y_a + jax.nn.sigmoid(g_b) * y_b
    return merged @ w_out


def channel_mixer(h, w_ffn_up, conv_w_ffn, w_ffn_down):
    u = h @ w_ffn_up
    gate, val = u[..., :D_FF], u[..., D_FF:]
    gate = causal_dwconv(gate, conv_w_ffn)
    return (jax.nn.silu(gate) * val) @ w_ffn_down


def setup_inputs(seed: int = 0) -> dict:
    key = jax.random.key(seed)
    ks = jax.random.split(key, 32)
    f32 = jnp.float32
    nrm = lambda k, shape, s: jax.random.normal(k, shape, f32) * s
    L = DEPTH
    return {
        "x": nrm(ks[0], (BATCH, SEQ, D_MODEL), 1.0),
        "c": nrm(ks[1], (BATCH, D_MODEL), 1.0),
        "w_ada": nrm(ks[2], (L, D_MODEL, N_ADA * D_MODEL), 0.5 * D_MODEL ** -0.5),
        "b_ada": nrm(ks[3], (L, N_ADA * D_MODEL), 0.02),
        "norm1_gain": 1.0 + nrm(ks[4], (L, D_MODEL), 0.02),
        "w_in": nrm(ks[5], (L, D_MODEL, N_IN), D_MODEL ** -0.5),
        "mu_shift": jax.random.uniform(ks[6], (L, N_SHIFT), f32),
        "w0": jax.random.uniform(ks[7], (L, D_RWKV), f32, -6.0, -1.0),
        "a0": nrm(ks[8], (L, D_RWKV), 0.1),
        "k_k": 0.85 + nrm(ks[9], (L, D_RWKV), 0.05),
        "k_a": 1.0 + nrm(ks[10], (L, D_RWKV), 0.05),
        "r_k": nrm(ks[11], (L, RWKV_HEADS, RWKV_HEAD_DIM), 0.1),
        "w_lora_decay": nrm(ks[12], (L, LORA_DECAY, D_RWKV), 0.5 * LORA_DECAY ** -0.5),
        "w_lora_iclr": nrm(ks[13], (L, LORA_ICLR, D_RWKV), 0.5 * LORA_ICLR ** -0.5),
        "w_lora_gate": nrm(ks[14], (L, LORA_GATE, D_RWKV), LORA_GATE ** -0.5),
        "lnx_w": 1.0 + nrm(ks[15], (L, D_RWKV), 0.02),
        "lnx_b": nrm(ks[16], (L, D_RWKV), 0.02),
        "conv_w_mix": nrm(ks[17], (L, CONV_WIDTH, D_CONV), CONV_WIDTH ** -0.5),
        "w_o_rwkv": nrm(ks[18], (L, D_RWKV, D_MODEL), D_RWKV ** -0.5),
        "w_o_conv": nrm(ks[19], (L, D_CONV, D_MODEL), D_CONV ** -0.5),
        "w_out": nrm(ks[20], (L, D_MODEL, D_MODEL), D_MODEL ** -0.5),
        "norm2_gain": 1.0 + nrm(ks[21], (L, D_MODEL), 0.02),
        "w_ffn_up": nrm(ks[22], (L, D_MODEL, 2 * D_FF), D_MODEL ** -0.5),
        "conv_w_ffn": nrm(ks[23], (L, CONV_WIDTH, D_FF), CONV_WIDTH ** -0.5),
        "w_ffn_down": nrm(ks[24], (L, D_FF, D_MODEL), D_FF ** -0.5),
        "final_gain": 1.0 + nrm(ks[25], (D_MODEL,), 0.02),
    }


def reference(x, c, w_ada, b_ada, norm1_gain, w_in, mu_shift, w0, a0, k_k, k_a, r_k,
              w_lora_decay, w_lora_iclr, w_lora_gate, lnx_w, lnx_b, conv_w_mix,
              w_o_rwkv, w_o_conv, w_out, norm2_gain, w_ffn_up, conv_w_ffn, w_ffn_down,
              final_gain):
    c_act = jax.nn.silu(c)
    for layer in range(DEPTH):
        mod = c_act @ w_ada[layer] + b_ada[layer]
        shift1, scale1, gate1, shift2, scale2, gate2 = jnp.split(mod, N_ADA, axis=-1)
        h = modulate(rmsnorm(x, norm1_gain[layer]), shift1, scale1)
        y = token_mixer(h, w_in[layer], mu_shift[layer], w0[layer], a0[layer], k_k[layer],
                        k_a[layer], r_k[layer], w_lora_decay[layer], w_lora_iclr[layer],
                        w_lora_gate[layer], lnx_w[layer], lnx_b[layer], conv_w_mix[layer],
                        w_o_rwkv[layer], w_o_conv[layer], w_out[layer])
        x = x + gate1[:, None, :] * y
        h = modulate(rmsnorm(x, norm2_gain[layer]), shift2, scale2)
        y = channel_mixer(h, w_ffn_up[layer], conv_w_ffn[layer], w_ffn_down[layer])
        x = x + gate2[:, None, :] * y
    return rmsnorm(x, final_gain)
```

```cpp
#include <hip/hip_runtime.h>
#include <cstdio>
#include <cstdint>
namespace pg8 {
#define PG8_LAS __attribute__((address_space(3)))
typedef unsigned short bf16_t;
typedef short bf16x8 __attribute__((ext_vector_type(8)));
typedef float f32x4 __attribute__((ext_vector_type(4)));
typedef unsigned u32x4 __attribute__((ext_vector_type(4)));
constexpr int BM = 256, BK = 64, HALF = 128, HTB = HALF * BK * 2  , STAGE_BYTES = 8 * HTB, NXCD = 8, WGM = 8;

__host__ __device__ __forceinline__ int lds_byte(int r, int c) { const int st = (r >> 4) * 2 + (c >> 5), rr = r & 15, cc = c & 31, ob = rr * 64 + cc * 2; return st * 1024 + (ob ^ (((ob >> 9) & 1) << 5)); }
__host__ __device__ __forceinline__ void stage_rc(int b, int& R, int& C) { const int st = b / 1024, sb = b % 1024, swz = sb ^ (((sb >> 9) & 1) << 5); R = (st >> 1) * 16 + swz / 64; C = (st & 1) * 32 + (swz % 64) / 2; }
__host__ __device__ __forceinline__ int perm32(int rho) { const int n = rho >> 4, i = rho & 15; return 8 * (i >> 2) + 4 * n + (i & 3); }

struct Unit { int pm, pn; };
struct Gemm { const bf16_t* A; const bf16_t* Bt; int M, N, K; int seg_tiles; size_t a_seg_bytes; };

struct StaticOrder {
    int nM, nN, nwg, G, c;
    __host__ __device__ void init(int M, int N, int G_, int c_) { nM = M / BM; nN = N / BM; nwg = nM * nN; G = G_; c = c_; }
    __host__ __device__ bool next(int i, Unit& u) const {
        const long L = (long)i * G + c; if (L >= nwg) return false;
        int wgid = (int)L; { const int q = nwg / NXCD, r = nwg % NXCD, xcd = wgid % NXCD, off = wgid / NXCD; wgid = (xcd < r ? xcd * (q + 1) : r * (q + 1) + (xcd - r) * q) + off; }
        const int nig = WGM * nN, gid = wgid / nig, fm = gid * WGM, gsz = (nM - fm) < WGM ? (nM - fm) : WGM;
        u.pm = fm + ((wgid % nig) % gsz); u.pn = (wgid % nig) / gsz; return true;
    }
    __device__ __forceinline__ void a_ready(const Unit&) const {}
    __device__ __forceinline__ void done(const Unit&) const {}
};

__device__ __forceinline__ unsigned cvt_pk_bf16(float lo, float hi) { unsigned r; asm volatile("v_cvt_pk_bf16_f32 %0, %1, %2" : "=v"(r) : "v"(lo), "v"(hi)); return r; }
__device__ __forceinline__ float bf_lo(unsigned w) { return __builtin_bit_cast(float, w << 16); }
__device__ __forceinline__ float bf_hi(unsigned w) { return __builtin_bit_cast(float, w & 0xffff0000u); }
__device__ __forceinline__ float sigmoidf_(float x) { return __builtin_amdgcn_rcpf(1.0f + __expf(-x)); }
__device__ __forceinline__ u32x4 pack8(const f32x4 v0, const f32x4 v1) { u32x4 w; w.x = cvt_pk_bf16(v0[0], v0[1]); w.y = cvt_pk_bf16(v0[2], v0[3]); w.z = cvt_pk_bf16(v1[0], v1[1]); w.w = cvt_pk_bf16(v1[2], v1[3]); return w; }
__device__ __forceinline__ void unpack8(const u32x4 w, f32x4& v0, f32x4& v1) { v0 = (f32x4){bf_lo(w.x), bf_hi(w.x), bf_lo(w.y), bf_hi(w.y)}; v1 = (f32x4){bf_lo(w.z), bf_hi(w.z), bf_lo(w.w), bf_hi(w.w)}; }

#define EPI_LOOP_BEGIN \
    _Pragma("unroll") for (int ai = 0; ai < 2; ++ai) _Pragma("unroll") for (int m = 0; m < 4; ++m) { const int row = row0 + ai * HALF + m * 16; \
    _Pragma("unroll") for (int bj = 0; bj < 2; ++bj) { const int col = col0 + bj * HALF; const f32x4 a0 = acc[ai][bj][m][0], a1 = acc[ai][bj][m][1];
#define EPI_LOOP_END } }

struct EpiProj {
    static constexpr bool PERM = true, AFTER_DRAIN = false, HAS_MID = false;
    bf16_t *PS, *PC, *PG;
    __device__ __forceinline__ void operator()(const f32x4 (&acc)[2][2][4][2], const Unit& u, int wr, int wc, int fr, int fq) const {
        bf16_t* base; int ld, colt;
        if (u.pn < 26) { base = PS; ld = 6656; colt = u.pn * BM; } else if (u.pn < 50) { base = PC; ld = 6144; colt = (u.pn - 26) * BM; } else { base = PG; ld = 8192; colt = (u.pn - 50) * BM; }
        const int row0 = u.pm * BM + wr * 64 + fr, col0 = colt + wc * 32 + 8 * fq;
        EPI_LOOP_BEGIN
            *(u32x4*)(base + (size_t)row * ld + col) = pack8(a0, a1);
        EPI_LOOP_END
    }
};
struct EpiPlain {
    static constexpr bool PERM = true, AFTER_DRAIN = false, HAS_MID = false;
    bf16_t* O; int ld;
    __device__ __forceinline__ void operator()(const f32x4 (&acc)[2][2][4][2], const Unit& u, int wr, int wc, int fr, int fq) const {
        const int row0 = u.pm * BM + wr * 64 + fr, col0 = u.pn * BM + wc * 32 + 8 * fq;
        EPI_LOOP_BEGIN
            *(u32x4*)(O + (size_t)row * ld + col) = pack8(a0, a1);
        EPI_LOOP_END
    }
};
struct EpiLora {
    static constexpr bool PERM = true, AFTER_DRAIN = false, HAS_MID = false;
    float* WD; bf16_t* ICLR; bf16_t* G; const float* w0p; const float* a0p;
    __device__ __forceinline__ void operator()(const f32x4 (&acc)[2][2][4][2], const Unit& u, int wr, int wc, int fr, int fq) const {
        const int seg = u.pn >> 3;
        const int row0 = u.pm * BM + wr * 64 + fr, col0 = (u.pn & 7) * BM + wc * 32 + 8 * fq;
        if (seg == 0) {
            EPI_LOOP_BEGIN
                const f32x4 b0 = *(const f32x4*)(w0p + col), b1 = *(const f32x4*)(w0p + col + 4);
                *(f32x4*)(WD + (size_t)row * 2048 + col) = b0 + a0; *(f32x4*)(WD + (size_t)row * 2048 + col + 4) = b1 + a1;
            EPI_LOOP_END
        } else if (seg == 1) {
            EPI_LOOP_BEGIN
                const f32x4 b0 = *(const f32x4*)(a0p + col), b1 = *(const f32x4*)(a0p + col + 4);
                f32x4 o0, o1;
#pragma unroll
                for (int e2 = 0; e2 < 4; ++e2) { o0[e2] = sigmoidf_(b0[e2] + a0[e2]); o1[e2] = sigmoidf_(b1[e2] + a1[e2]); }
                *(u32x4*)(ICLR + (size_t)row * 2048 + col) = pack8(o0, o1);
            EPI_LOOP_END
        } else {
            EPI_LOOP_BEGIN
                *(u32x4*)(G + (size_t)row * 2048 + col) = pack8(a0, a1);
            EPI_LOOP_END
        }
    }
};
struct EpiMix {
    static constexpr bool PERM = true, AFTER_DRAIN = false, HAS_MID = true;
    const bf16_t* PG; bf16_t* MG;
    __device__ __forceinline__ void mid(f32x4 (&acc)[2][2][4][2], const Unit& u, int wr, int wc, int fr, int fq) const {
        asm volatile("" : "+v"(fr), "+v"(fq));
        const int row0 = u.pm * BM + wr * 64 + fr, col0 = u.pn * BM + wc * 32 + 8 * fq;
#pragma unroll
        for (int ai = 0; ai < 2; ++ai)
#pragma unroll
            for (int mp = 0; mp < 2; ++mp) {
                u32x4 ga[4], gb[4];
#pragma unroll
                for (int mm = 0; mm < 2; ++mm)
#pragma unroll
                    for (int bj = 0; bj < 2; ++bj) { const bf16_t* p = PG + (size_t)(row0 + ai * HALF + (mp * 2 + mm) * 16) * 8192 + col0 + bj * HALF; ga[mm * 2 + bj] = *(const u32x4*)p; gb[mm * 2 + bj] = *(const u32x4*)(p + 4096); }
                asm volatile("" : "+v"(ga[0]), "+v"(ga[1]), "+v"(ga[2]), "+v"(ga[3]), "+v"(gb[0]), "+v"(gb[1]), "+v"(gb[2]), "+v"(gb[3]));
#pragma unroll
                for (int mm = 0; mm < 2; ++mm)
#pragma unroll
                    for (int bj = 0; bj < 2; ++bj) { const int m = mp * 2 + mm; f32x4 a0, a1, b0, b1; unpack8(ga[mm * 2 + bj], a0, a1); unpack8(gb[mm * 2 + bj], b0, b1);
#pragma unroll
                        for (int e2 = 0; e2 < 4; ++e2) {
                            acc[ai][bj][m][0][e2] *= (1.0f + __expf(-b0[e2])) * __builtin_amdgcn_rcpf(1.0f + __expf(-a0[e2]));
                            acc[ai][bj][m][1][e2] *= (1.0f + __expf(-b1[e2])) * __builtin_amdgcn_rcpf(1.0f + __expf(-a1[e2])); } }
            }
    }
    __device__ __forceinline__ void operator()(const f32x4 (&acc)[2][2][4][2], const Unit& u, int wr, int wc, int fr, int fq) const {
        const int row0 = u.pm * BM + wr * 64 + fr, col0 = u.pn * BM + wc * 32 + 8 * fq;
#pragma unroll
        for (int ai = 0; ai < 2; ++ai) {
            u32x4 gw[8];
#pragma unroll
            for (int m = 0; m < 4; ++m)
#pragma unroll
                for (int bj = 0; bj < 2; ++bj) gw[m * 2 + bj] = *(const u32x4*)(PG + (size_t)(row0 + ai * HALF + m * 16) * 8192 + 4096 + col0 + bj * HALF);
            asm volatile("" : "+v"(gw[0]), "+v"(gw[1]), "+v"(gw[2]), "+v"(gw[3]), "+v"(gw[4]), "+v"(gw[5]), "+v"(gw[6]), "+v"(gw[7]));
#pragma unroll
            for (int m = 0; m < 4; ++m)
#pragma unroll
                for (int bj = 0; bj < 2; ++bj) { const int row = row0 + ai * HALF + m * 16, col = col0 + bj * HALF; const f32x4 a0 = acc[ai][bj][m][0], a1 = acc[ai][bj][m][1];
                    f32x4 g0, g1; unpack8(gw[m * 2 + bj], g0, g1); f32x4 o0, o1;
#pragma unroll
                    for (int e2 = 0; e2 < 4; ++e2) { o0[e2] = sigmoidf_(g0[e2]) * a0[e2]; o1[e2] = sigmoidf_(g1[e2]) * a1[e2]; }
                    *(u32x4*)(MG + (size_t)row * 4096 + col) = pack8(o0, o1); }
        }
    }
};
struct EpiResid {
    static constexpr bool PERM = true, AFTER_DRAIN = false, HAS_MID = false;
    const float* X; float* OUT; const float* gate;
    __device__ __forceinline__ void operator()(const f32x4 (&acc)[2][2][4][2], const Unit& u, int wr, int wc, int fr, int fq) const {
        const int row0 = u.pm * BM + wr * 64 + fr, col0 = u.pn * BM + wc * 32 + 8 * fq;
        const float* gp = gate + (size_t)(u.pm >> 5) * 24576;
        f32x4 gt[2][2];
#pragma unroll
        for (int bj = 0; bj < 2; ++bj) { gt[bj][0] = *(const f32x4*)(gp + col0 + bj * HALF); gt[bj][1] = *(const f32x4*)(gp + col0 + bj * HALF + 4); }
#pragma unroll
        for (int ai = 0; ai < 2; ++ai) {
            f32x4 xv[16];
#pragma unroll
            for (int m = 0; m < 4; ++m)
#pragma unroll
                for (int bj = 0; bj < 2; ++bj) { const float* xp = X + (size_t)(row0 + ai * HALF + m * 16) * 4096 + col0 + bj * HALF; xv[(m * 2 + bj) * 2] = *(const f32x4*)xp; xv[(m * 2 + bj) * 2 + 1] = *(const f32x4*)(xp + 4); }
            asm volatile("" : "+v"(xv[0]), "+v"(xv[1]), "+v"(xv[2]), "+v"(xv[3]), "+v"(xv[4]), "+v"(xv[5]), "+v"(xv[6]), "+v"(xv[7]), "+v"(xv[8]), "+v"(xv[9]), "+v"(xv[10]), "+v"(xv[11]), "+v"(xv[12]), "+v"(xv[13]), "+v"(xv[14]), "+v"(xv[15]));
#pragma unroll
            for (int m = 0; m < 4; ++m)
#pragma unroll
                for (int bj = 0; bj < 2; ++bj) { float* op = OUT + (size_t)(row0 + ai * HALF + m * 16) * 4096 + col0 + bj * HALF;
                    *(f32x4*)op = xv[(m * 2 + bj) * 2] + gt[bj][0] * acc[ai][bj][m][0]; *(f32x4*)(op + 4) = xv[(m * 2 + bj) * 2 + 1] + gt[bj][1] * acc[ai][bj][m][1]; }
        }
    }
};
struct EpiAct {
    static constexpr bool PERM = true, AFTER_DRAIN = false, HAS_MID = false;
    bf16_t* ACT; const float* cw; bf16_t* HG0; bf16_t* HV0; bf16_t* HG1;
    __device__ __forceinline__ void operator()(const f32x4 (&acc)[2][2][4][2], const Unit& u, int wr, int wc, int fr, int fq) const {
        constexpr int FFc = 11008;
        const int ch0 = u.pn * 128 + wc * 32 + 8 * fq;
        float w0[8], w1[8], w2[8];
#pragma unroll
        for (int h = 0; h < 2; ++h) { const f32x4 a = *(const f32x4*)(cw + ch0 + 4 * h), b = *(const f32x4*)(cw + FFc + ch0 + 4 * h), c = *(const f32x4*)(cw + 2 * FFc + ch0 + 4 * h);
#pragma unroll
            for (int ee = 0; ee < 4; ++ee) { w0[4 * h + ee] = a[ee]; w1[4 * h + ee] = b[ee]; w2[4 * h + ee] = c[ee]; } }
#pragma unroll
        for (int ai = 0; ai < 2; ++ai) {
            const int blk = u.pm * 4 + ai * 2 + wr;
            const int rowb = u.pm * BM + ai * HALF + wr * 64 + fr;
#pragma unroll
            for (int m = 0; m < 4; ++m) {
                float o[8];
#pragma unroll
                for (int n = 0; n < 2; ++n)
#pragma unroll
                    for (int ee = 0; ee < 4; ++ee) {
                        const int c = 4 * n + ee; const float x = acc[ai][0][m][n][ee]; float y;
                        asm volatile("s_nop 1\n\t"
                                     "v_mul_f32 %0, %1, %4\n\t"
                                     "v_fmac_f32_dpp %0, %1, %3 row_shr:1 row_mask:0xf bank_mask:0xf\n\t"
                                     "v_fmac_f32_dpp %0, %1, %2 row_shr:2 row_mask:0xf bank_mask:0xf"
                                     : "=&v"(y) : "v"(x), "v"(w0[c]), "v"(w1[c]), "v"(w2[c]));
                        if (m > 0) { const float xp = acc[ai][0][m - 1][n][ee];
                            asm volatile("s_nop 1\n\t"
                                         "v_fmac_f32_dpp %0, %1, %3 row_shl:15 row_mask:0xf bank_mask:0xf\n\t"
                                         "v_fmac_f32_dpp %0, %1, %2 row_shl:14 row_mask:0xf bank_mask:0xf"
                                         : "+v"(y) : "v"(xp), "v"(w0[c]), "v"(w1[c])); }
                        o[c] = y * sigmoidf_(y) * acc[ai][1][m][n][ee];
                    }
                const u32x4 ov = pack8((f32x4){o[0], o[1], o[2], o[3]}, (f32x4){o[4], o[5], o[6], o[7]});
                if (m > 0 || fr >= 2) *(u32x4*)(ACT + (size_t)(rowb + m * 16) * FFc + ch0) = ov;
                if (m == 0 && fr < 2) { *(u32x4*)(HG0 + ((size_t)blk * 2 + fr) * FFc + ch0) = pack8(acc[ai][0][0][0], acc[ai][0][0][1]); *(u32x4*)(HV0 + ((size_t)blk * 2 + fr) * FFc + ch0) = pack8(acc[ai][1][0][0], acc[ai][1][0][1]); }
                if (m == 3 && fr >= 14) *(u32x4*)(HG1 + ((size_t)blk * 2 + (fr - 14)) * FFc + ch0) = pack8(acc[ai][0][3][0], acc[ai][0][3][1]);
            }
        }
    }
};
struct EpiDelta {
    static constexpr bool PERM = true, AFTER_DRAIN = false, HAS_MID = false;
    bf16_t* OUT; const float* gate;
    __device__ __forceinline__ void operator()(const f32x4 (&acc)[2][2][4][2], const Unit& u, int wr, int wc, int fr, int fq) const {
        const int row0 = u.pm * BM + wr * 64 + fr, col0 = u.pn * BM + wc * 32 + 8 * fq;
        const float* gp = gate + (size_t)(u.pm >> 5) * 24576;
        f32x4 gt[2][2];
#pragma unroll
        for (int bj = 0; bj < 2; ++bj) { gt[bj][0] = *(const f32x4*)(gp + col0 + bj * HALF); gt[bj][1] = *(const f32x4*)(gp + col0 + bj * HALF + 4); }
        EPI_LOOP_BEGIN
            *(u32x4*)(OUT + (size_t)row * 4096 + col) = pack8(gt[bj][0] * a0, gt[bj][1] * a1);
        EPI_LOOP_END
    }
};
struct EpiDeltaSum {
    static constexpr bool PERM = true, AFTER_DRAIN = false, HAS_MID = false;
    bf16_t* OUT; const float* gate; const bf16_t* ADD;
    __device__ __forceinline__ void operator()(const f32x4 (&acc)[2][2][4][2], const Unit& u, int wr, int wc, int fr, int fq) const {
        const int row0 = u.pm * BM + wr * 64 + fr, col0 = u.pn * BM + wc * 32 + 8 * fq;
        const float* gp = gate + (size_t)(u.pm >> 5) * 24576;
        f32x4 gt[2][2];
#pragma unroll
        for (int bj = 0; bj < 2; ++bj) { gt[bj][0] = *(const f32x4*)(gp + col0 + bj * HALF); gt[bj][1] = *(const f32x4*)(gp + col0 + bj * HALF + 4); }
        EPI_LOOP_BEGIN
            f32x4 d0, d1; unpack8(*(const u32x4*)(ADD + (size_t)row * 4096 + col), d0, d1);
            *(u32x4*)(OUT + (size_t)row * 4096 + col) = pack8(gt[bj][0] * a0 + d0, gt[bj][1] * a1 + d1);
        EPI_LOOP_END
    }
};
#undef EPI_LOOP_BEGIN
#undef EPI_LOOP_END

template <class Epi, class Sched, bool ALIGN_EPI = false, bool SP2 = false, int HALFK_PN = 0>
__device__ __forceinline__ void gemm_phase(PG8_LAS unsigned char* lds, const Gemm g, const Sched& S, const Epi& E) {
    int tid_ = threadIdx.x; asm volatile("" : "+v"(tid_));
    const int tid = tid_, wid = __builtin_amdgcn_readfirstlane(tid >> 6), lane = tid & 63, wr = wid >> 2, wc = wid & 3, fr = lane & 15, fq = lane >> 4;
    const int K = g.K, ntf = K / BK;
    unsigned voffA[2], voffB[2];
#pragma unroll
    for (int i = 0; i < 2; ++i) { int R, C; stage_rc(tid * 16 + i * 8192, R, C); const int Rb = Epi::PERM ? ((R & ~31) + perm32(R & 31)) : R;
        voffA[i] = (unsigned)(R * K + C) * 2u; voffB[i] = (unsigned)(Rb * K + C) * 2u; }
    const size_t kstep = (size_t)(BK * 2);
    const size_t hstep = (size_t)HALF * K * 2;
    const size_t tstep = 2 * hstep;
    const unsigned ldsw = (unsigned)wid * 1024u;
    const int aoff = lds_byte(wr * 64 + fr, fq * 8), boff = lds_byte(wc * 32 + fr, fq * 8);
#define PG8_SA(b, h) (((b) * 2 + (h)) * HTB)
#define PG8_SB(b, h) ((4 + (b) * 2 + (h)) * HTB)
#define PG8_STAGE(bufoff, gbase, voff) do { _Pragma("unroll") for (int _i = 0; _i < 2; ++_i) \
        __builtin_amdgcn_global_load_lds((const unsigned*)((const char*)(gbase) + (voff)[_i]), (PG8_LAS unsigned*)(lds + (bufoff) + ldsw + _i * 8192), 16, 0, 0); } while (0)
#define PG8_LDA(dst, b, h) do { _Pragma("unroll") for (int m = 0; m < 4; ++m) _Pragma("unroll") for (int k = 0; k < 2; ++k) dst[m][k] = *(const PG8_LAS bf16x8*)(lds + PG8_SA(b, h) + aoff + m * 2048 + k * 1024); } while (0)
#define PG8_LDB(dst, b, h) do { _Pragma("unroll") for (int n = 0; n < 2; ++n) _Pragma("unroll") for (int k = 0; k < 2; ++k) dst[n][k] = *(const PG8_LAS bf16x8*)(lds + PG8_SB(b, h) + boff + n * 2048 + k * 1024); } while (0)
#define PG8_MMA(ai, bj, At, Bt) do { __builtin_amdgcn_s_setprio(1); _Pragma("unroll") for (int m = 0; m < 4; ++m) _Pragma("unroll") for (int n = 0; n < 2; ++n) _Pragma("unroll") for (int k = 0; k < 2; ++k) \
        acc[ai][bj][m][n] = __builtin_amdgcn_mfma_f32_16x16x32_bf16(Bt[n][k], At[m][k], acc[ai][bj][m][n], 0, 0, 0); __builtin_amdgcn_s_setprio(0); } while (0)
#define PG8_WAIT_V(n) asm volatile("s_waitcnt vmcnt(" #n ")" ::: "memory")
#define PG8_WAIT_L(n) asm volatile("s_waitcnt lgkmcnt(" #n ")" ::: "memory")
#define PG8_BAR __builtin_amdgcn_s_barrier()
#define PG8_SCHED __builtin_amdgcn_sched_barrier(0)
    Unit cur, nxt; int ui = 0;
    if (!S.next(0, cur)) return;
    f32x4 acc[2][2][4][2];
#pragma unroll
    for (int a = 0; a < 2; ++a)
#pragma unroll
        for (int b = 0; b < 2; ++b)
#pragma unroll
            for (int m = 0; m < 4; ++m)
#pragma unroll
                for (int n = 0; n < 2; ++n) acc[a][b][m][n] = (f32x4){0.f, 0.f, 0.f, 0.f};
    bf16x8 At[4][2], B0[2][2], B1[2][2];
    const char* cA = (const char*)g.A + (size_t)cur.pm * tstep + (size_t)(cur.pn / g.seg_tiles) * g.a_seg_bytes; const char* cB = (const char*)g.Bt + (size_t)cur.pn * tstep;
    S.a_ready(cur);
    if constexpr (SP2) {
        PG8_STAGE(PG8_SB(0, 0), cB, voffB); PG8_STAGE(PG8_SB(0, 1), cB + hstep, voffB); PG8_STAGE(PG8_SA(0, 0), cA, voffA); PG8_STAGE(PG8_SA(0, 1), cA + hstep, voffA);
        if (wr == 1) PG8_BAR;
        PG8_WAIT_V(2); PG8_BAR;
        PG8_STAGE(PG8_SB(1, 0), cB + kstep, voffB); PG8_STAGE(PG8_SA(1, 0), cA + kstep, voffA); PG8_STAGE(PG8_SB(1, 1), cB + hstep + kstep, voffB);
        PG8_WAIT_V(6); PG8_BAR;
    } else {
        PG8_STAGE(PG8_SB(0, 0), cB, voffB); PG8_STAGE(PG8_SA(0, 0), cA, voffA); PG8_STAGE(PG8_SB(0, 1), cB + hstep, voffB); PG8_STAGE(PG8_SA(0, 1), cA + hstep, voffA);
        if (wr == 1) PG8_BAR;
        PG8_WAIT_V(4); PG8_BAR;
        PG8_STAGE(PG8_SB(1, 0), cB + kstep, voffB); PG8_STAGE(PG8_SA(1, 0), cA + kstep, voffA); PG8_STAGE(PG8_SB(1, 1), cB + hstep + kstep, voffB);
        PG8_WAIT_V(6); PG8_BAR;
    }
    for (;;) {
        const bool has_next = S.next(ui + 1, nxt);
        const char* nA = has_next ? (const char*)g.A + (size_t)nxt.pm * tstep + (size_t)(nxt.pn / g.seg_tiles) * g.a_seg_bytes : cA; const char* nB = has_next ? (const char*)g.Bt + (size_t)nxt.pn * tstep : cB;
        int nt = ntf;
        if constexpr (HALFK_PN > 0) { if (cur.pn < HALFK_PN) nt = ntf / 2; }
        for (int t = 0; t < nt; t += 2) {
            const bool last = (t == nt - 2);
            const char* a1 = cA + (size_t)(t + 1) * kstep;
            const char* a2 = last ? nA : cA + (size_t)(t + 2) * kstep; const char* b2 = last ? nB : cB + (size_t)(t + 2) * kstep;
            const char* a3 = a2 + kstep; const char* b3 = b2 + kstep;
            if (last && has_next) S.a_ready(nxt);
            if constexpr (Epi::HAS_MID) { if (t == ntf / 2) E.mid(acc, cur, wr, wc, fr, fq); }
            if constexpr (SP2) {
            PG8_LDB(B0, 0, 0); PG8_LDB(B1, 0, 1); PG8_SCHED; PG8_LDA(At, 0, 0); PG8_STAGE(PG8_SA(1, 1), a1 + hstep, voffA);
            PG8_WAIT_V(8); PG8_WAIT_L(0); PG8_BAR; PG8_MMA(0, 0, At, B0); PG8_MMA(0, 1, At, B1); PG8_BAR; PG8_SCHED;
            PG8_LDA(At, 0, 1); PG8_STAGE(PG8_SB(0, 0), b2, voffB); PG8_STAGE(PG8_SB(0, 1), b2 + hstep, voffB); PG8_STAGE(PG8_SA(0, 0), a2, voffA);
            PG8_WAIT_V(8); PG8_WAIT_L(0); PG8_BAR; PG8_MMA(1, 0, At, B0); PG8_MMA(1, 1, At, B1); PG8_BAR; PG8_SCHED;
            PG8_LDB(B0, 1, 0); PG8_LDB(B1, 1, 1); PG8_SCHED; PG8_LDA(At, 1, 0); PG8_STAGE(PG8_SA(0, 1), a2 + hstep, voffA);
            PG8_WAIT_V(8); PG8_WAIT_L(0); PG8_BAR; PG8_MMA(0, 0, At, B0); PG8_MMA(0, 1, At, B1); PG8_BAR; PG8_SCHED;
            PG8_LDA(At, 1, 1); PG8_STAGE(PG8_SB(1, 0), b3, voffB); PG8_STAGE(PG8_SB(1, 1), b3 + hstep, voffB); PG8_STAGE(PG8_SA(1, 0), a3, voffA);
            PG8_WAIT_V(8); PG8_WAIT_L(0); PG8_BAR; PG8_MMA(1, 0, At, B0); PG8_MMA(1, 1, At, B1); PG8_BAR; PG8_SCHED;
            } else {
            PG8_LDB(B0, 0, 0); PG8_SCHED; PG8_LDA(At, 0, 0); PG8_STAGE(PG8_SA(1, 1), a1 + hstep, voffA);
            PG8_WAIT_L(8); PG8_BAR; PG8_WAIT_L(0); PG8_MMA(0, 0, At, B0); PG8_BAR; PG8_SCHED;
            PG8_LDB(B1, 0, 1); PG8_STAGE(PG8_SB(0, 0), b2, voffB);
            PG8_BAR; PG8_WAIT_L(0); PG8_MMA(0, 1, At, B1); PG8_BAR;
            PG8_LDA(At, 0, 1); PG8_STAGE(PG8_SA(0, 0), a2, voffA);
            PG8_BAR; PG8_WAIT_L(0); PG8_MMA(1, 0, At, B0); PG8_BAR; PG8_SCHED;
            PG8_STAGE(PG8_SB(0, 1), b2 + hstep, voffB);
            PG8_WAIT_V(6); PG8_BAR; PG8_MMA(1, 1, At, B1); PG8_BAR;
            PG8_LDB(B0, 1, 0); PG8_SCHED; PG8_LDA(At, 1, 0); PG8_STAGE(PG8_SA(0, 1), a2 + hstep, voffA);
            PG8_WAIT_L(8); PG8_BAR; PG8_WAIT_L(0); PG8_MMA(0, 0, At, B0); PG8_BAR; PG8_SCHED;
            PG8_LDB(B1, 1, 1); PG8_STAGE(PG8_SB(1, 0), b3, voffB);
            PG8_BAR; PG8_WAIT_L(0); PG8_MMA(0, 1, At, B1); PG8_BAR;
            PG8_LDA(At, 1, 1); PG8_STAGE(PG8_SA(1, 0), a3, voffA);
            PG8_BAR; PG8_WAIT_L(0); PG8_MMA(1, 0, At, B0); PG8_BAR; PG8_SCHED;
            PG8_STAGE(PG8_SB(1, 1), b3 + hstep, voffB);
            PG8_WAIT_V(6); PG8_BAR; PG8_MMA(1, 1, At, B1); PG8_BAR;
            }
        }
        if constexpr (ALIGN_EPI) { if (wr == 0) PG8_BAR; }
        if constexpr (!Epi::AFTER_DRAIN) { E(acc, cur, wr, wc, fr, fq); S.done(cur); }
        if (!has_next) break;
#pragma unroll
        for (int a = 0; a < 2; ++a)
#pragma unroll
            for (int b = 0; b < 2; ++b)
#pragma unroll
                for (int m = 0; m < 4; ++m)
#pragma unroll
                    for (int n = 0; n < 2; ++n) acc[a][b][m][n] = (f32x4){0.f, 0.f, 0.f, 0.f};
        cur = nxt; cA = nA; cB = nB; ++ui;
        if constexpr (ALIGN_EPI) { if (wr == 1) PG8_BAR; }
    }
    PG8_WAIT_V(0);
    if constexpr (!ALIGN_EPI) { if (wr == 0) PG8_BAR; }
    PG8_BAR;
    if constexpr (Epi::AFTER_DRAIN) { E.fused(acc, cur, wr, wc, fr, fq, lds, wid, lane); S.done(cur); }
#undef PG8_SA
#undef PG8_SB
#undef PG8_STAGE
#undef PG8_LDA
#undef PG8_LDB
#undef PG8_MMA
#undef PG8_WAIT_V
#undef PG8_WAIT_L
#undef PG8_BAR
#undef PG8_SCHED
}
}

#ifndef PG8_SP2
#define PG8_SP2 true
#endif
#ifndef PG8_ALIGN
#define PG8_ALIGN true
#endif
#ifndef PROBE_REPS
#define PROBE_REPS 1,1,1,1,1,1,1,1,1,1,1,1,1,1,1,1,1,1
#endif
#ifndef MK_N_LAUNCHES
#define MK_N_LAUNCHES 1
#endif

constexpr int NWAVES = 8;
constexpr int BATCH = 2, T = 8192, D = 4096, DR = 2048, NH = 32, HD = 64, FF = 11008;
constexpr int M = BATCH * T;
constexpr int N_SHIFT = 6592, N_IN = 20928;
constexpr int N_INP = 20992;
constexpr int LD_PS = 6656, LD_PC = 6144, LD_PG = 8192, NUP = 2 * FF;
constexpr int NADA = 6 * D;
constexpr int NSEG = 32, SEGLEN = T / NSEG;
constexpr float NORM_EPS = 1e-6f, LNX_EPS = 64e-5f;

constexpr size_t MiB = 1u << 20;
constexpr size_t WS_CTL = 0, CTL_ZERO_BYTES = 1 * MiB;
constexpr size_t WS_PART = 1 * MiB;
constexpr size_t WS_MOD = 7 * MiB;
constexpr size_t WS_WLORA = 8 * MiB;
constexpr size_t WS_WOCAT = 12 * MiB, WS_WOUT = 44 * MiB;
constexpr size_t WS_WIN = 76 * MiB;
constexpr size_t WS_H = 240 * MiB;
constexpr size_t WS_PS = 368 * MiB;
constexpr size_t WS_PC = 576 * MiB;
constexpr size_t WS_PG = 768 * MiB;
constexpr size_t WS_ALORA = 76 * MiB;
constexpr size_t WS_OCB = 240 * MiB;
constexpr size_t WS_G = 164 * MiB;
constexpr size_t WS_BONUS = 228 * MiB;
constexpr size_t WS_CEND = 230 * MiB;
constexpr size_t WS_WD = 1024 * MiB, WS_ICLR = 1152 * MiB, WS_R = 1280 * MiB, WS_KK = 1408 * MiB;
constexpr size_t WS_BV = 576 * MiB;
constexpr size_t WS_PBUF = 704 * MiB, WS_QBUF = 736 * MiB;
constexpr size_t WS_PT = 1152 * MiB;
constexpr size_t WS_YQ = 368 * MiB;
constexpr size_t WS_SST = 100 * MiB;
constexpr size_t WS_PQ = 1024 * MiB;
constexpr size_t WS_MERGED = 1280 * MiB;
constexpr size_t WS_H2 = 12 * MiB;
constexpr size_t WS_WUP = 140 * MiB;
constexpr size_t WS_WDOWN = 312 * MiB;
constexpr size_t WS_HG0 = 398 * MiB, WS_HV0 = 410 * MiB, WS_HG1 = 422 * MiB;
constexpr size_t WS_ACT = 1086 * MiB;
constexpr size_t WS_D1 = 440 * MiB, WS_D2 = 568 * MiB;
constexpr size_t WS_END = 1536 * MiB;
constexpr int CW_TMO = 0, CW_CODE = 1, CW_BAR = 4096, CW_MODCNT = 150000;

constexpr int RING_OFF = 0, RING_BYTES = 131072;
constexpr int LDSCTL_OFF = RING_BYTES, MISC_OFF = LDSCTL_OFF + 320;
constexpr int LDS_BYTES = 147456;

#define GAS __attribute__((address_space(1)))
#define LAS __attribute__((address_space(3)))
typedef unsigned short bf16;
typedef unsigned v4u __attribute__((ext_vector_type(4)));
typedef unsigned v2u __attribute__((ext_vector_type(2)));
typedef float f32x4 __attribute__((ext_vector_type(4)));
typedef float f32x2 __attribute__((ext_vector_type(2)));
typedef GAS unsigned gu32;
#define RLX_AGENT __ATOMIC_RELAXED, __HIP_MEMORY_SCOPE_AGENT
#define LDS_WAIT() asm volatile("s_waitcnt lgkmcnt(0)" ::: "memory")
#define VM_WAIT() asm volatile("s_waitcnt vmcnt(0)" ::: "memory")
__device__ __forceinline__ unsigned f2bf(float f) { unsigned u = __builtin_bit_cast(unsigned, f); return (u + 0x7fffu + ((u >> 16) & 1u)) >> 16; }
__device__ __forceinline__ unsigned pk2(float lo, float hi) { return f2bf(lo) | (f2bf(hi) << 16); }
__device__ __forceinline__ float bflo(unsigned w) { return __builtin_bit_cast(float, w << 16); }
__device__ __forceinline__ float bfhi(unsigned w) { return __builtin_bit_cast(float, w & 0xffff0000u); }
__device__ __forceinline__ float bf1(bf16 h) { return __builtin_bit_cast(float, ((unsigned)h) << 16); }
__device__ __forceinline__ float sigm(float x) { return __builtin_amdgcn_rcpf(1.0f + __expf(-x)); }
__device__ __forceinline__ float wave_sum(float v) {
#pragma unroll
    for (int o = 1; o < 64; o <<= 1) v += __shfl_xor(v, o);
    return v;
}

#define DPP_ADD(v, ctrl) ((v) + __builtin_bit_cast(float, __builtin_amdgcn_update_dpp(0, __builtin_bit_cast(int, (v)), (ctrl), 0xf, 0xf, true)))
__device__ __forceinline__ float wave_sum_dpp(float v) {
    v = DPP_ADD(v, 0xB1);
    v = DPP_ADD(v, 0x4E);
    v = DPP_ADD(v, 0x141);
    v = DPP_ADD(v, 0x140);
    const int iv = __builtin_bit_cast(int, v);
    const float r0 = __builtin_bit_cast(float, __builtin_amdgcn_readlane(iv, 0)), r1 = __builtin_bit_cast(float, __builtin_amdgcn_readlane(iv, 16));
    const float r2 = __builtin_bit_cast(float, __builtin_amdgcn_readlane(iv, 32)), r3 = __builtin_bit_cast(float, __builtin_amdgcn_readlane(iv, 48));
    return (r0 + r1) + (r2 + r3);
}

#define XB_TMO      128
#define XB_XCNT(j)  (256  + 64 * (j))
#define XB_XSUB(j)  (1280 + 64 * (j))
#define XB_XGEN(j)  (2304 + 64 * (j))
#define XB_TOP      3328
#define XB_TOPGEN   3392
#define XCD_BAR_WORDS 3456
#define XB_SPIN_CAP (1u << 18)

__device__ __forceinline__ unsigned xb_ld(unsigned* p)              { return __hip_atomic_load(p, __ATOMIC_RELAXED, __HIP_MEMORY_SCOPE_AGENT); }
__device__ __forceinline__ unsigned xb_add(unsigned* p, unsigned v) { return __hip_atomic_fetch_add(p, v, __ATOMIC_RELAXED, __HIP_MEMORY_SCOPE_AGENT); }
__device__ __forceinline__ unsigned xb_xcc_id() { return (unsigned)__builtin_amdgcn_s_getreg((3 << 11) | 20) & 0xFu; }
#define XB_SPIN(cond, bar) do { unsigned _sp = 0; while (cond) { __builtin_amdgcn_s_sleep(1); \
    if ((++_sp & 255u) == 0u) { if (xb_ld(&(bar)[XB_TMO])) break; if (_sp > XB_SPIN_CAP) { atomicAdd(&(bar)[XB_TMO], 1u); break; } } } } while (0)

struct XcdBarrier {
    unsigned* bar; unsigned x;
    volatile LAS unsigned* st;
};
__device__ __forceinline__ XcdBarrier xcd_barrier_post(unsigned* bar, volatile LAS unsigned* st) {
    XcdBarrier b; b.bar = bar; b.x = xb_xcc_id(); b.st = st;
    if (threadIdx.x == 0) (void)xb_add(&bar[XB_XCNT(b.x)], 1u);
    return b;
}
__device__ __forceinline__ void xcd_barrier_complete(unsigned* bar, unsigned x, unsigned& nloc, unsigned& nx) {
    const unsigned G = gridDim.x * gridDim.y * gridDim.z;
    unsigned sum, cnt, mine, sp = 0u;
    for (;;) {
        sum = 0u; cnt = 0u; mine = 0u;
#pragma unroll
        for (unsigned j = 0; j < 16; ++j) { const unsigned c = xb_ld(&bar[XB_XCNT(j)]); sum += c; cnt += (c > 0u) ? 1u : 0u; mine = (j == x) ? c : mine; }
        if (sum == G) break;
        __builtin_amdgcn_s_sleep(1);
        if ((++sp & 255u) == 0u) { if (xb_ld(&bar[XB_TMO])) break; if (sp > XB_SPIN_CAP) { atomicAdd(&bar[XB_TMO], 1u); break; } }
    }
    nloc = mine > 0u ? mine : 1u; nx = cnt > 0u ? cnt : 1u;
}
__device__ __forceinline__ void xcd_barrier(const XcdBarrier& b) {
    asm volatile("s_waitcnt vmcnt(0)" ::: "memory");
    __syncthreads();
    if (threadIdx.x == 0) {
        unsigned* bar = b.bar;
        __builtin_amdgcn_s_waitcnt(0);
        unsigned nloc = b.st[0], nx = b.st[1];
        if (nloc == 0u) { xcd_barrier_complete(bar, b.x, nloc, nx); b.st[0] = nloc; b.st[1] = nx; }
        const unsigned old = xb_add(&bar[XB_XSUB(b.x)], 1u);
        const unsigned gen = old / nloc;
        if (old + 1u == (gen + 1u) * nloc) {
            __builtin_amdgcn_fence(__ATOMIC_RELEASE, "agent");
            asm volatile("s_waitcnt vmcnt(0)" ::: "memory");
            const unsigned og = xb_add(&bar[XB_TOP], 1u);
            const unsigned tg = og / nx;
            if (og + 1u == (tg + 1u) * nx) xb_add(&bar[XB_TOPGEN], 1u);
            else XB_SPIN(xb_ld(&bar[XB_TOPGEN]) == tg, bar);
            __builtin_amdgcn_fence(__ATOMIC_ACQUIRE, "agent");
            xb_add(&bar[XB_XGEN(b.x)], 1u);
            asm volatile("s_waitcnt vmcnt(0)" ::: "memory");
        } else {
            XB_SPIN(xb_ld(&bar[XB_XGEN(b.x)]) == gen, bar);
            __builtin_amdgcn_fence(__ATOMIC_ACQUIRE, "agent");
            asm volatile("s_waitcnt vmcnt(0)" ::: "memory");
        }
    }
    __syncthreads();
}

__device__ __forceinline__ int fresh_lane() { unsigned l; asm volatile("v_mbcnt_lo_u32_b32 %0, -1, 0\n\tv_mbcnt_hi_u32_b32 %0, -1, %0" : "=v"(l)); return (int)l; }
__device__ __forceinline__ void transpose_item(const float* W, int N, int Kd, bf16* WT, int kb, int nb, int dest_row0, LAS unsigned* scr, int lane) {
    const int k0 = kb * 64, n0 = nb * 64;
    const float* src = W + (size_t)k0 * N + n0 + lane;
#pragma unroll 8
    for (int i = 0; i < 32; ++i) { const float f0 = __builtin_nontemporal_load(src + (size_t)(2 * i) * N), f1 = __builtin_nontemporal_load(src + (size_t)(2 * i + 1) * N); scr[i * 65 + lane] = pk2(f0, f1); }
    LDS_WAIT(); asm volatile("" ::: "memory");
    const int c = lane & 7;
#pragma unroll
    for (int j = 0; j < 8; ++j) { const int n = (lane >> 3) + 8 * j; const LAS unsigned* s = scr + (4 * c) * 65 + n;
        v4u o; o.x = s[0]; o.y = s[65]; o.z = s[130]; o.w = s[195];
        *(GAS v4u*)(WT + (size_t)(dest_row0 + n) * Kd + k0 + 8 * c) = o; }
    LDS_WAIT(); asm volatile("" ::: "memory");
}

__device__ __forceinline__ void p0_prologue(const float* const* in, unsigned char* ws, LAS unsigned char* lds, int gw, int NGW, int tid, int lane, int wave) {
    const float* c_in = in[1]; const float* w_ada = in[2];
    LAS float* sc = (LAS float*)lds;
    for (int i = tid; i < 2 * D; i += NWAVES * 64) { const float v = c_in[i]; sc[i] = v / (1.0f + __expf(-v)); }
    __syncthreads();
    LAS unsigned* scr = (LAS unsigned*)(lds + 32768 + wave * 8320);
    float* PART = (float*)(ws + WS_PART);
    constexpr int GEMV_ITEMS = 192 * 32;
    constexpr int I_IN = 64 * 327, I_OR = 32 * 64, I_OC = 32 * 64, I_OUT = 64 * 64;
    constexpr int NITEMS = GEMV_ITEMS + I_IN + I_OR + I_OC + I_OUT;
    for (int it = gw; it < NITEMS; it += NGW) {
        int r = it;
        if (r < GEMV_ITEMS) {
            const int cg = r % 192, ks = r / 192, n0 = cg * 128 + lane * 2, k0 = ks * 128;
            f32x2 acc0 = {0.f, 0.f}, acc1 = {0.f, 0.f};
            const float* wp = w_ada + (size_t)k0 * NADA + n0;
#pragma unroll 8
            for (int k = 0; k < 128; ++k) { const f32x2 wv = __builtin_nontemporal_load((const f32x2*)(wp + (size_t)k * NADA)); const float s0 = sc[k0 + k], s1 = sc[D + k0 + k]; acc0 += wv * s0; acc1 += wv * s1; }
            float* p0 = PART + (size_t)(ks * 2 + 0) * NADA + n0; float* p1 = PART + (size_t)(ks * 2 + 1) * NADA + n0;
            __hip_atomic_store(p0, acc0.x, RLX_AGENT); __hip_atomic_store(p0 + 1, acc0.y, RLX_AGENT); __hip_atomic_store(p1, acc1.x, RLX_AGENT); __hip_atomic_store(p1 + 1, acc1.y, RLX_AGENT);
            asm volatile("s_waitcnt vmcnt(0)" ::: "memory");
            unsigned arrived = 0u;
            if (lane == 0) arrived = __hip_atomic_fetch_add((unsigned*)(ws + WS_CTL) + CW_MODCNT + cg, 1u, RLX_AGENT);
            arrived = (unsigned)__builtin_amdgcn_readfirstlane((int)arrived);
            if (arrived == 31u) {
                float* MOD = (float*)(ws + WS_MOD); const float* bp = in[3] + n0;
                float s00 = bp[0], s01 = bp[1], s10 = s00, s11 = s01;
#pragma unroll 8
                for (int q = 0; q < 32; ++q) { const float* r0 = PART + (size_t)(q * 2) * NADA + n0; const float* r1 = r0 + NADA;
                    s00 += __hip_atomic_load(r0, RLX_AGENT); s01 += __hip_atomic_load(r0 + 1, RLX_AGENT); s10 += __hip_atomic_load(r1, RLX_AGENT); s11 += __hip_atomic_load(r1 + 1, RLX_AGENT); }
                *(f32x2*)(MOD + n0) = (f32x2){s00, s01}; *(f32x2*)(MOD + NADA + n0) = (f32x2){s10, s11};
            }
            continue;
        }
        r -= GEMV_ITEMS;
        if (r < I_IN) { const int kb = r / 327, nb = r % 327, n0 = nb * 64; transpose_item(in[5], N_IN, D, (bf16*)(ws + WS_WIN), kb, nb, n0 + (n0 >= N_SHIFT ? 64 : 0), scr, lane); continue; }
        r -= I_IN;
        if (r < I_OR) { transpose_item(in[18], D, D, (bf16*)(ws + WS_WOCAT), r / 64, r % 64, (r % 64) * 64, scr, lane); continue; }
        r -= I_OR;
        if (r < I_OC) { transpose_item(in[19], D, D, (bf16*)(ws + WS_WOCAT) + DR, r / 64, r % 64, (r % 64) * 64, scr, lane); continue; }
        r -= I_OC;
        transpose_item(in[20], D, D, (bf16*)(ws + WS_WOUT), r / 64, r % 64, (r % 64) * 64, scr, lane);
    }
    const int gt = gw * 64 + lane, NT = NGW * 64;
    bf16* WL = (bf16*)(ws + WS_WLORA);
    for (int e = gt; e < 3 * 2048 * 256; e += NT) {
        const int seg = e / (2048 * 256), kk = (e / 2048) % 256, n = e % 2048;
        float v = 0.f;
        if (seg == 0) { if (kk < 96) v = in[12][(size_t)kk * 2048 + n]; }
        else if (seg == 1) { if (kk < 96) v = in[13][(size_t)kk * 2048 + n]; }
        else v = in[14][(size_t)kk * 2048 + n];
        WL[((size_t)seg * 2048 + n) * 256 + kk] = (bf16)f2bf(v);
    }
    GAS v4u* padp = (GAS v4u*)((bf16*)(ws + WS_WIN) + (size_t)N_SHIFT * D);
    for (int e = gt; e < 64 * D / 8; e += NT) padp[e] = (v4u){0u, 0u, 0u, 0u};
}

__device__ __forceinline__ void p0b_mod(const float* b_ada, unsigned char* ws, int gt, int NT) {
    const float* PART = (const float*)(ws + WS_PART); float* MOD = (float*)(ws + WS_MOD);
    for (int e = gt; e < 2 * NADA; e += NT) { const int b = e / NADA, n = e % NADA; float s = b_ada[n];
#pragma unroll 8
        for (int ks = 0; ks < 32; ++ks) s += PART[(size_t)(ks * 2 + b) * NADA + n];
        MOD[e] = s; }
}

template <bool ADD_D1>
__device__ __forceinline__ void norm_mod_rows(const float* src, const bf16* d1, const float* gain, const float* mod, int shift_off, int scale_off, bf16* dst, LAS unsigned char* lds, int gw, int NGW, int tid, int lane) {
    asm volatile("" : "+v"(tid), "+v"(lane));
    LAS f32x4* gsl = (LAS f32x4*)lds; LAS f32x4* shl = (LAS f32x4*)(lds + 16384);
    for (int b = 0; b < BATCH; ++b) {
        __syncthreads();
        for (int c4 = tid; c4 < D / 4; c4 += NWAVES * 64) { const f32x4 g = *(const f32x4*)(gain + 4 * c4), s = *(const f32x4*)(mod + (size_t)b * NADA + scale_off + 4 * c4);
            gsl[c4] = g * (s + 1.0f); shl[c4] = *(const f32x4*)(mod + (size_t)b * NADA + shift_off + 4 * c4); }
        __syncthreads();
        for (int m = b * T + gw; m < (b + 1) * T; m += NGW) {
            const GAS f32x4* xr = (const GAS f32x4*)(src + (size_t)m * D) + lane;
            f32x4 v[16];
#pragma unroll
            for (int j = 0; j < 16; ++j) v[j] = __builtin_nontemporal_load(xr + 64 * j);
            asm volatile("" : "+v"(v[0]), "+v"(v[1]), "+v"(v[2]), "+v"(v[3]), "+v"(v[4]), "+v"(v[5]), "+v"(v[6]), "+v"(v[7]), "+v"(v[8]), "+v"(v[9]), "+v"(v[10]), "+v"(v[11]), "+v"(v[12]), "+v"(v[13]), "+v"(v[14]), "+v"(v[15]));
            if (ADD_D1) { const GAS v2u* dr = (const GAS v2u*)(d1 + (size_t)m * D) + lane; v2u dv[16];
#pragma unroll
                for (int j = 0; j < 16; ++j) dv[j] = dr[64 * j];
#pragma unroll
                for (int j = 0; j < 16; ++j) v[j] += (f32x4){bflo(dv[j].x), bfhi(dv[j].x), bflo(dv[j].y), bfhi(dv[j].y)}; }
            float ss = 0.f;
#pragma unroll
            for (int j = 0; j < 16; ++j) ss += (v[j].x * v[j].x + v[j].y * v[j].y) + (v[j].z * v[j].z + v[j].w * v[j].w);
            const float rstd = __builtin_amdgcn_rsqf(wave_sum(ss) * (1.0f / D) + NORM_EPS);
            GAS v2u* o8 = (GAS v2u*)(dst + (size_t)m * D) + lane;
#pragma unroll
            for (int j = 0; j < 16; ++j) { const f32x4 h = v[j] * rstd * gsl[lane + 64 * j] + shl[lane + 64 * j]; v2u w; w.x = pk2(h.x, h.y); w.y = pk2(h.z, h.w); o8[64 * j] = w; }
        }
    }
    __syncthreads();
}

__device__ __forceinline__ void final_norm_rows(const float* x, const bf16* d12, float* out, const float* gain, LAS unsigned char* lds, int gw, int NGW, int tid, int lane) {
    asm volatile("" : "+v"(tid), "+v"(lane));
    LAS f32x4* gsl = (LAS f32x4*)lds;
    for (int c4 = tid; c4 < D / 4; c4 += NWAVES * 64) gsl[c4] = *(const f32x4*)(gain + 4 * c4);
    __syncthreads();
    for (int m = gw; m < M; m += NGW) {
        const GAS f32x4* xr = (const GAS f32x4*)(x + (size_t)m * D) + lane; const GAS v2u* ar = (const GAS v2u*)(d12 + (size_t)m * D) + lane;
        f32x4 v[16]; v2u da[16];
#pragma unroll
        for (int j = 0; j < 16; ++j) { v[j] = __builtin_nontemporal_load(xr + 64 * j); da[j] = __builtin_nontemporal_load(ar + 64 * j); }
        asm volatile("" : "+v"(v[0]), "+v"(v[1]), "+v"(v[2]), "+v"(v[3]), "+v"(v[4]), "+v"(v[5]), "+v"(v[6]), "+v"(v[7]), "+v"(v[8]), "+v"(v[9]), "+v"(v[10]), "+v"(v[11]), "+v"(v[12]), "+v"(v[13]), "+v"(v[14]), "+v"(v[15]));
        float ss = 0.f;
#pragma unroll
        for (int j = 0; j < 16; ++j) { v[j] += (f32x4){bflo(da[j].x), bfhi(da[j].x), bflo(da[j].y), bfhi(da[j].y)};
            ss += (v[j].x * v[j].x + v[j].y * v[j].y) + (v[j].z * v[j].z + v[j].w * v[j].w); }
        const float rstd = __builtin_amdgcn_rsqf(wave_sum(ss) * (1.0f / D) + NORM_EPS);
        GAS f32x4* orow = (GAS f32x4*)(out + (size_t)m * D) + lane;
#pragma unroll
        for (int j = 0; j < 16; ++j) __builtin_nontemporal_store(v[j] * rstd * gsl[lane + 64 * j], orow + 64 * j);
    }
}

__device__ __forceinline__ void p3_prep(const float* mu, const float* convw, unsigned char* ws, int gw, int NGW, int lane) {
    const bf16* PS = (const bf16*)(ws + WS_PS); const bf16* PC = (const bf16*)(ws + WS_PC);
    bf16* AL = (bf16*)(ws + WS_ALORA); bf16* CB = (bf16*)(ws + WS_OCB) + DR;
    constexpr int TB = 32, PD = 4;
    for (int item = gw; item < 4 * (M / TB); item += NGW) {
        const int q = item & 3, m0 = (item >> 2) * TB, t0 = m0 % T;
        const int c8 = (q * 64 + lane) * 8;
        f32x4 w[3][2];
#pragma unroll
        for (int k = 0; k < 3; ++k) { w[k][0] = *(const f32x4*)(convw + k * 2048 + c8); w[k][1] = *(const f32x4*)(convw + k * 2048 + c8 + 4); }
        const int seg = q < 2 ? q : 2, kkA = (q == 3 ? 128 : 0) + lane, kkB = kkA + 64;
        const int colA = (seg == 0 ? 6144 : (seg == 1 ? 6240 : 6336)) + kkA, colB = colA + 64;
        const bool actB = seg == 2 || kkB < 96;
        const float muA = mu[colA], muB = actB ? mu[colB] : 0.f;
        float z1[8], z2[8], pA = 0.f, pB = 0.f;
#pragma unroll
        for (int e = 0; e < 8; ++e) { z1[e] = 0.f; z2[e] = 0.f; }
        if (t0 != 0) {
            const bf16* r1 = PC + (size_t)(m0 - 1) * LD_PC; const bf16* r2 = r1 - LD_PC;
            const v4u c1 = *(const GAS v4u*)(r1 + 2048 + c8), x1 = *(const GAS v4u*)(r1 + 4096 + c8), c2 = *(const GAS v4u*)(r2 + 2048 + c8), x2 = *(const GAS v4u*)(r2 + 4096 + c8);
            z1[0] = bflo(c1.x) * bflo(x1.x); z1[1] = bfhi(c1.x) * bfhi(x1.x); z1[2] = bflo(c1.y) * bflo(x1.y); z1[3] = bfhi(c1.y) * bfhi(x1.y);
            z1[4] = bflo(c1.z) * bflo(x1.z); z1[5] = bfhi(c1.z) * bfhi(x1.z); z1[6] = bflo(c1.w) * bflo(x1.w); z1[7] = bfhi(c1.w) * bfhi(x1.w);
            z2[0] = bflo(c2.x) * bflo(x2.x); z2[1] = bfhi(c2.x) * bfhi(x2.x); z2[2] = bflo(c2.y) * bflo(x2.y); z2[3] = bfhi(c2.y) * bfhi(x2.y);
            z2[4] = bflo(c2.z) * bflo(x2.z); z2[5] = bfhi(c2.z) * bfhi(x2.z); z2[6] = bflo(c2.w) * bflo(x2.w); z2[7] = bfhi(c2.w) * bfhi(x2.w);
            const bf16* ps1 = PS + (size_t)(m0 - 1) * LD_PS; pA = bf1(ps1[colA]); pB = actB ? bf1(ps1[colB]) : 0.f;
        }
        v4u ncc[PD], ncx[PD], ncb[PD]; bf16 nla[PD], nlb[PD];
#pragma unroll
        for (int d = 0; d < PD; ++d) { const bf16* r = PC + (size_t)(m0 + d) * LD_PC; ncb[d] = *(const GAS v4u*)(r + c8); ncc[d] = *(const GAS v4u*)(r + 2048 + c8); ncx[d] = *(const GAS v4u*)(r + 4096 + c8);
            const bf16* ps = PS + (size_t)(m0 + d) * LD_PS; nla[d] = ps[colA]; nlb[d] = actB ? ps[colB] : (bf16)0; }
        for (int i0 = 0; i0 < TB; i0 += PD) {
#pragma unroll
            for (int d = 0; d < PD; ++d) {
                const int m = m0 + i0 + d;
                const v4u cc = ncc[d], cx = ncx[d], cb = ncb[d]; const float cA = bf1(nla[d]), cB = bf1(nlb[d]);
                { const int mn = m0 + (i0 + d + PD < TB ? i0 + d + PD : TB - 1); const bf16* r = PC + (size_t)mn * LD_PC; ncb[d] = *(const GAS v4u*)(r + c8); ncc[d] = *(const GAS v4u*)(r + 2048 + c8); ncx[d] = *(const GAS v4u*)(r + 4096 + c8);
                  const bf16* ps = PS + (size_t)mn * LD_PS; nla[d] = ps[colA]; nlb[d] = actB ? ps[colB] : (bf16)0; }
                float z[8];
                z[0] = bflo(cc.x) * bflo(cx.x); z[1] = bfhi(cc.x) * bfhi(cx.x); z[2] = bflo(cc.y) * bflo(cx.y); z[3] = bfhi(cc.y) * bfhi(cx.y);
                z[4] = bflo(cc.z) * bflo(cx.z); z[5] = bfhi(cc.z) * bfhi(cx.z); z[6] = bflo(cc.w) * bflo(cx.w); z[7] = bfhi(cc.w) * bfhi(cx.w);
                float y[8];
#pragma unroll
                for (int e = 0; e < 8; ++e) { y[e] = w[2][e >> 2][e & 3] * z[e] + w[1][e >> 2][e & 3] * z1[e] + w[0][e >> 2][e & 3] * z2[e]; z2[e] = z1[e]; z1[e] = z[e]; }
                v4u o; o.x = pk2(bflo(cb.x) * y[0], bfhi(cb.x) * y[1]); o.y = pk2(bflo(cb.y) * y[2], bfhi(cb.y) * y[3]); o.z = pk2(bflo(cb.z) * y[4], bfhi(cb.z) * y[5]); o.w = pk2(bflo(cb.w) * y[6], bfhi(cb.w) * y[7]);
                *(GAS v4u*)(CB + (size_t)m * D + c8) = o;
                const float sA = cA + (pA - cA) * muA, sB = cB + (pB - cB) * muB; pA = cA; pB = cB;
                float vA, vB;
                if (seg == 0) { vA = 1.0f - 2.0f * __builtin_amdgcn_rcpf(1.0f + __expf(2.0f * sA)); vB = 1.0f - 2.0f * __builtin_amdgcn_rcpf(1.0f + __expf(2.0f * sB)); }
                else if (seg == 1) { vA = sA; vB = sB; }
                else { vA = sigm(sA); vB = sigm(sB); }
                bf16* al = AL + ((size_t)seg * M + m) * 256;
                al[kkA] = (bf16)f2bf(vA); al[kkB] = actB ? (bf16)f2bf(vB) : (bf16)0;
                if (q < 2) { al[128 + lane] = (bf16)0; al[192 + lane] = (bf16)0; }
            }
        }
    }
}

__device__ __forceinline__ void p5_scanprep(const float* mu, const float* k_k, const float* k_a, const float* r_k, unsigned char* ws, float* dout, int gw, int NGW, int lane) {
    const bf16* PS = (const bf16*)(ws + WS_PS); const bf16* ICLR = (const bf16*)(ws + WS_ICLR); float* WDio = (float*)(ws + WS_WD);
    float* Ro = (float*)(ws + WS_R); float* Ko = (float*)(ws + WS_KK); float* Vo = dout; float* Ao = dout + (size_t)M * DR; float* Bo = (float*)(ws + WS_BV); float* BON = (float*)(ws + WS_BONUS); float* CEND = (float*)(ws + WS_CEND);
    for (int item = gw; item < 8 * (M / 64); item += NGW) {
        const int cg = item & 7, tb = item >> 3, c0 = cg * 256 + lane * 4;
        const f32x4 mur = *(const f32x4*)(mu + c0), muk = *(const f32x4*)(mu + 2048 + c0), muv = *(const f32x4*)(mu + 4096 + c0);
        const f32x4 kkw = *(const f32x4*)(k_k + c0), kaw = *(const f32x4*)(k_a + c0), rkw = *(const f32x4*)(r_k + c0);
        const int m0 = tb * 64;
        const size_t ovh = ((size_t)((m0 / T) * NH + cg * 4 + (lane >> 4)) * T + (m0 % T)) * 64 + (lane & 15) * 4;
        f32x4 pr = {0.f, 0.f, 0.f, 0.f}, pk = pr, pv = pr, cum = {1.f, 1.f, 1.f, 1.f};
        if ((m0 % T) != 0) { const bf16* p = PS + (size_t)(m0 - 1) * LD_PS + c0;
            const v2u a = *(const GAS v2u*)p, b = *(const GAS v2u*)(p + 2048), c = *(const GAS v2u*)(p + 4096);
            pr = (f32x4){bflo(a.x), bfhi(a.x), bflo(a.y), bfhi(a.y)}; pk = (f32x4){bflo(b.x), bfhi(b.x), bflo(b.y), bfhi(b.y)}; pv = (f32x4){bflo(c.x), bfhi(c.x), bflo(c.y), bfhi(c.y)}; }
        v2u na, nb, nc, nicp; f32x4 nwp;
        { const bf16* p = PS + (size_t)m0 * LD_PS + c0; na = *(const GAS v2u*)p; nb = *(const GAS v2u*)(p + 2048); nc = *(const GAS v2u*)(p + 4096);
          nicp = *(const GAS v2u*)(ICLR + (size_t)m0 * DR + c0); nwp = *(const f32x4*)(WDio + (size_t)m0 * DR + c0); }
#pragma unroll 2
        for (int i = 0; i < 64; ++i) {
            const int m = m0 + i;
            const v2u a = na, b = nb, c = nc, icp = nicp; const f32x4 wp = nwp;
            { const int mn = m0 + (i < 63 ? i + 1 : 63); const bf16* p = PS + (size_t)mn * LD_PS + c0; na = __builtin_nontemporal_load((const GAS v2u*)p); nb = __builtin_nontemporal_load((const GAS v2u*)(p + 2048)); nc = __builtin_nontemporal_load((const GAS v2u*)(p + 4096));
              nicp = __builtin_nontemporal_load((const GAS v2u*)(ICLR + (size_t)mn * DR + c0)); nwp = __builtin_nontemporal_load((const f32x4*)(WDio + (size_t)mn * DR + c0)); }
            const f32x4 cr = (f32x4){bflo(a.x), bfhi(a.x), bflo(a.y), bfhi(a.y)}, ck = (f32x4){bflo(b.x), bfhi(b.x), bflo(b.y), bfhi(b.y)}, cv = (f32x4){bflo(c.x), bfhi(c.x), bflo(c.y), bfhi(c.y)};
            const f32x4 ic = (f32x4){bflo(icp.x), bfhi(icp.x), bflo(icp.y), bfhi(icp.y)};
            f32x4 dec;
#pragma unroll
            for (int e = 0; e < 4; ++e) { const float z = -wp[e]; const float sp = fmaxf(z, 0.f) + __logf(1.0f + __expf(-fabsf(z))); dec[e] = __expf(-__expf(-sp - 0.5f)); }
            const f32x4 cprev = cum; cum = cum * dec;
            const f32x4 cinv = (f32x4){__builtin_amdgcn_rcpf(cum.x), __builtin_amdgcn_rcpf(cum.y), __builtin_amdgcn_rcpf(cum.z), __builtin_amdgcn_rcpf(cum.w)};
            const f32x4 r = cr + (pr - cr) * mur, kr = ck + (pk - ck) * muk, v = cv + (pv - cv) * muv;
            pr = cr; pk = ck; pv = cv;
            const f32x4 kkv = kr * kkw;
            float ss = (kkv.x * kkv.x + kkv.y * kkv.y) + (kkv.z * kkv.z + kkv.w * kkv.w);
            ss += __shfl_xor(ss, 1); ss += __shfl_xor(ss, 2); ss += __shfl_xor(ss, 4); ss += __shfl_xor(ss, 8);
            const float inv = __builtin_amdgcn_rsqf(fmaxf(ss, 1e-24f));
            const f32x4 kk = kkv * inv;
            const f32x4 k = kr * ((ic - 1.0f) * kaw + 1.0f);
            float bs = (r.x * k.x * rkw.x + r.y * k.y * rkw.y) + (r.z * k.z * rkw.z + r.w * k.w * rkw.w);
            bs += __shfl_xor(bs, 1); bs += __shfl_xor(bs, 2); bs += __shfl_xor(bs, 4); bs += __shfl_xor(bs, 8);
            const size_t o = (size_t)m * DR + c0;
            __builtin_nontemporal_store(r * cum, (f32x4*)(Ro + o)); __builtin_nontemporal_store(k * cinv, (f32x4*)(Ko + o)); { v2u vw; vw.x = pk2(v.x, v.y); vw.y = pk2(v.z, v.w); __builtin_nontemporal_store(vw, (GAS v2u*)((bf16*)Vo + ovh + (size_t)i * 64)); } __builtin_nontemporal_store(-kk * cprev, (f32x4*)(Ao + o)); __builtin_nontemporal_store(kk * ic * cinv, (f32x4*)(Bo + o));
            if ((lane & 15) == 0) BON[(size_t)m * NH + cg * 4 + (lane >> 4)] = bs;
        }
        *(f32x4*)(CEND + (size_t)tb * DR + c0) = cum;
    }
}

#define SCAN_SA16(s0, s1, s2, s3, av, S, B) asm volatile( \
        "s_nop 1\n\t" \
        "v_fmac_f32_dpp %0, %4, %5 row_newbcast:0 row_mask:0xf bank_mask:0xf\n\t" \
        "v_fmac_f32_dpp %1, %4, %6 row_newbcast:1 row_mask:0xf bank_mask:0xf\n\t" \
        "v_fmac_f32_dpp %2, %4, %7 row_newbcast:2 row_mask:0xf bank_mask:0xf\n\t" \
        "v_fmac_f32_dpp %3, %4, %8 row_newbcast:3 row_mask:0xf bank_mask:0xf\n\t" \
        "v_fmac_f32_dpp %0, %4, %9 row_newbcast:4 row_mask:0xf bank_mask:0xf\n\t" \
        "v_fmac_f32_dpp %1, %4, %10 row_newbcast:5 row_mask:0xf bank_mask:0xf\n\t" \
        "v_fmac_f32_dpp %2, %4, %11 row_newbcast:6 row_mask:0xf bank_mask:0xf\n\t" \
        "v_fmac_f32_dpp %3, %4, %12 row_newbcast:7 row_mask:0xf bank_mask:0xf\n\t" \
        "v_fmac_f32_dpp %0, %4, %13 row_newbcast:8 row_mask:0xf bank_mask:0xf\n\t" \
        "v_fmac_f32_dpp %1, %4, %14 row_newbcast:9 row_mask:0xf bank_mask:0xf\n\t" \
        "v_fmac_f32_dpp %2, %4, %15 row_newbcast:10 row_mask:0xf bank_mask:0xf\n\t" \
        "v_fmac_f32_dpp %3, %4, %16 row_newbcast:11 row_mask:0xf bank_mask:0xf\n\t" \
        "v_fmac_f32_dpp %0, %4, %17 row_newbcast:12 row_mask:0xf bank_mask:0xf\n\t" \
        "v_fmac_f32_dpp %1, %4, %18 row_newbcast:13 row_mask:0xf bank_mask:0xf\n\t" \
        "v_fmac_f32_dpp %2, %4, %19 row_newbcast:14 row_mask:0xf bank_mask:0xf\n\t" \
        "v_fmac_f32_dpp %3, %4, %20 row_newbcast:15 row_mask:0xf bank_mask:0xf\n\t" \
        : "+v"(s0), "+v"(s1), "+v"(s2), "+v"(s3) : "v"(av), "v"(S[(B)+0]), "v"(S[(B)+1]), "v"(S[(B)+2]), "v"(S[(B)+3]), "v"(S[(B)+4]), "v"(S[(B)+5]), "v"(S[(B)+6]), "v"(S[(B)+7]), "v"(S[(B)+8]), "v"(S[(B)+9]), "v"(S[(B)+10]), "v"(S[(B)+11]), "v"(S[(B)+12]), "v"(S[(B)+13]), "v"(S[(B)+14]), "v"(S[(B)+15]))
#define SCAN_SA16X(s0, s1, s2, s3, av, S, E) asm volatile( \
        "s_nop 1\n\t" \
        "v_fmac_f32_dpp %0, %4, %5 row_newbcast:0 row_mask:0xf bank_mask:0xf\n\t" \
        "v_fmac_f32_dpp %1, %4, %6 row_newbcast:1 row_mask:0xf bank_mask:0xf\n\t" \
        "v_fmac_f32_dpp %2, %4, %7 row_newbcast:2 row_mask:0xf bank_mask:0xf\n\t" \
        "v_fmac_f32_dpp %3, %4, %8 row_newbcast:3 row_mask:0xf bank_mask:0xf\n\t" \
        "v_fmac_f32_dpp %0, %4, %9 row_newbcast:4 row_mask:0xf bank_mask:0xf\n\t" \
        "v_fmac_f32_dpp %1, %4, %10 row_newbcast:5 row_mask:0xf bank_mask:0xf\n\t" \
        "v_fmac_f32_dpp %2, %4, %11 row_newbcast:6 row_mask:0xf bank_mask:0xf\n\t" \
        "v_fmac_f32_dpp %3, %4, %12 row_newbcast:7 row_mask:0xf bank_mask:0xf\n\t" \
        "v_fmac_f32_dpp %0, %4, %13 row_newbcast:8 row_mask:0xf bank_mask:0xf\n\t" \
        "v_fmac_f32_dpp %1, %4, %14 row_newbcast:9 row_mask:0xf bank_mask:0xf\n\t" \
        "v_fmac_f32_dpp %2, %4, %15 row_newbcast:10 row_mask:0xf bank_mask:0xf\n\t" \
        "v_fmac_f32_dpp %3, %4, %16 row_newbcast:11 row_mask:0xf bank_mask:0xf\n\t" \
        "v_fmac_f32_dpp %0, %4, %17 row_newbcast:12 row_mask:0xf bank_mask:0xf\n\t" \
        "v_fmac_f32_dpp %1, %4, %18 row_newbcast:13 row_mask:0xf bank_mask:0xf\n\t" \
        "v_fmac_f32_dpp %2, %4, %19 row_newbcast:14 row_mask:0xf bank_mask:0xf\n\t" \
        "v_fmac_f32_dpp %3, %4, %20 row_newbcast:15 row_mask:0xf bank_mask:0xf\n\t" \
        : "+v"(s0), "+v"(s1), "+v"(s2), "+v"(s3) : "v"(av), "v"(S[4*0+(E)]), "v"(S[4*1+(E)]), "v"(S[4*2+(E)]), "v"(S[4*3+(E)]), "v"(S[4*4+(E)]), "v"(S[4*5+(E)]), "v"(S[4*6+(E)]), "v"(S[4*7+(E)]), "v"(S[4*8+(E)]), "v"(S[4*9+(E)]), "v"(S[4*10+(E)]), "v"(S[4*11+(E)]), "v"(S[4*12+(E)]), "v"(S[4*13+(E)]), "v"(S[4*14+(E)]), "v"(S[4*15+(E)]))
#define SCAN_UPD16_P(S, B, wv, bv, sa) asm volatile( \
        "s_nop 1\n\t" \
        "v_mul_f32_dpp %0, %16, %0 row_newbcast:0 row_mask:0xf bank_mask:0xf\n\t" \
        "v_mul_f32_dpp %1, %16, %1 row_newbcast:1 row_mask:0xf bank_mask:0xf\n\t" \
        "v_mul_f32_dpp %2, %16, %2 row_newbcast:2 row_mask:0xf bank_mask:0xf\n\t" \
        "v_mul_f32_dpp %3, %16, %3 row_newbcast:3 row_mask:0xf bank_mask:0xf\n\t" \
        "v_mul_f32_dpp %4, %16, %4 row_newbcast:4 row_mask:0xf bank_mask:0xf\n\t" \
        "v_mul_f32_dpp %5, %16, %5 row_newbcast:5 row_mask:0xf bank_mask:0xf\n\t" \
        "v_mul_f32_dpp %6, %16, %6 row_newbcast:6 row_mask:0xf bank_mask:0xf\n\t" \
        "v_mul_f32_dpp %7, %16, %7 row_newbcast:7 row_mask:0xf bank_mask:0xf\n\t" \
        "v_mul_f32_dpp %8, %16, %8 row_newbcast:8 row_mask:0xf bank_mask:0xf\n\t" \
        "v_mul_f32_dpp %9, %16, %9 row_newbcast:9 row_mask:0xf bank_mask:0xf\n\t" \
        "v_mul_f32_dpp %10, %16, %10 row_newbcast:10 row_mask:0xf bank_mask:0xf\n\t" \
        "v_mul_f32_dpp %11, %16, %11 row_newbcast:11 row_mask:0xf bank_mask:0xf\n\t" \
        "v_mul_f32_dpp %12, %16, %12 row_newbcast:12 row_mask:0xf bank_mask:0xf\n\t" \
        "v_mul_f32_dpp %13, %16, %13 row_newbcast:13 row_mask:0xf bank_mask:0xf\n\t" \
        "v_mul_f32_dpp %14, %16, %14 row_newbcast:14 row_mask:0xf bank_mask:0xf\n\t" \
        "v_mul_f32_dpp %15, %16, %15 row_newbcast:15 row_mask:0xf bank_mask:0xf\n\t" \
        "v_fmac_f32_dpp %0, %17, %18 row_newbcast:0 row_mask:0xf bank_mask:0xf\n\t" \
        "v_fmac_f32_dpp %1, %17, %18 row_newbcast:1 row_mask:0xf bank_mask:0xf\n\t" \
        "v_fmac_f32_dpp %2, %17, %18 row_newbcast:2 row_mask:0xf bank_mask:0xf\n\t" \
        "v_fmac_f32_dpp %3, %17, %18 row_newbcast:3 row_mask:0xf bank_mask:0xf\n\t" \
        "v_fmac_f32_dpp %4, %17, %18 row_newbcast:4 row_mask:0xf bank_mask:0xf\n\t" \
        "v_fmac_f32_dpp %5, %17, %18 row_newbcast:5 row_mask:0xf bank_mask:0xf\n\t" \
        "v_fmac_f32_dpp %6, %17, %18 row_newbcast:6 row_mask:0xf bank_mask:0xf\n\t" \
        "v_fmac_f32_dpp %7, %17, %18 row_newbcast:7 row_mask:0xf bank_mask:0xf\n\t" \
        "v_fmac_f32_dpp %8, %17, %18 row_newbcast:8 row_mask:0xf bank_mask:0xf\n\t" \
        "v_fmac_f32_dpp %9, %17, %18 row_newbcast:9 row_mask:0xf bank_mask:0xf\n\t" \
        "v_fmac_f32_dpp %10, %17, %18 row_newbcast:10 row_mask:0xf bank_mask:0xf\n\t" \
        "v_fmac_f32_dpp %11, %17, %18 row_newbcast:11 row_mask:0xf bank_mask:0xf\n\t" \
        "v_fmac_f32_dpp %12, %17, %18 row_newbcast:12 row_mask:0xf bank_mask:0xf\n\t" \
        "v_fmac_f32_dpp %13, %17, %18 row_newbcast:13 row_mask:0xf bank_mask:0xf\n\t" \
        "v_fmac_f32_dpp %14, %17, %18 row_newbcast:14 row_mask:0xf bank_mask:0xf\n\t" \
        "v_fmac_f32_dpp %15, %17, %18 row_newbcast:15 row_mask:0xf bank_mask:0xf\n\t" \
        : "+v"(S[(B)+0]), "+v"(S[(B)+1]), "+v"(S[(B)+2]), "+v"(S[(B)+3]), "+v"(S[(B)+4]), "+v"(S[(B)+5]), "+v"(S[(B)+6]), "+v"(S[(B)+7]), "+v"(S[(B)+8]), "+v"(S[(B)+9]), "+v"(S[(B)+10]), "+v"(S[(B)+11]), "+v"(S[(B)+12]), "+v"(S[(B)+13]), "+v"(S[(B)+14]), "+v"(S[(B)+15]) : "v"(wv), "v"(bv), "v"(sa))
#define SCAN_UPD16_Q(S, B, wv, bv, sa, kv, vv) asm volatile( \
        "s_nop 1\n\t" \
        "v_mul_f32_dpp %0, %16, %0 row_newbcast:0 row_mask:0xf bank_mask:0xf\n\t" \
        "v_mul_f32_dpp %1, %16, %1 row_newbcast:1 row_mask:0xf bank_mask:0xf\n\t" \
        "v_mul_f32_dpp %2, %16, %2 row_newbcast:2 row_mask:0xf bank_mask:0xf\n\t" \
        "v_mul_f32_dpp %3, %16, %3 row_newbcast:3 row_mask:0xf bank_mask:0xf\n\t" \
        "v_mul_f32_dpp %4, %16, %4 row_newbcast:4 row_mask:0xf bank_mask:0xf\n\t" \
        "v_mul_f32_dpp %5, %16, %5 row_newbcast:5 row_mask:0xf bank_mask:0xf\n\t" \
        "v_mul_f32_dpp %6, %16, %6 row_newbcast:6 row_mask:0xf bank_mask:0xf\n\t" \
        "v_mul_f32_dpp %7, %16, %7 row_newbcast:7 row_mask:0xf bank_mask:0xf\n\t" \
        "v_mul_f32_dpp %8, %16, %8 row_newbcast:8 row_mask:0xf bank_mask:0xf\n\t" \
        "v_mul_f32_dpp %9, %16, %9 row_newbcast:9 row_mask:0xf bank_mask:0xf\n\t" \
        "v_mul_f32_dpp %10, %16, %10 row_newbcast:10 row_mask:0xf bank_mask:0xf\n\t" \
        "v_mul_f32_dpp %11, %16, %11 row_newbcast:11 row_mask:0xf bank_mask:0xf\n\t" \
        "v_mul_f32_dpp %12, %16, %12 row_newbcast:12 row_mask:0xf bank_mask:0xf\n\t" \
        "v_mul_f32_dpp %13, %16, %13 row_newbcast:13 row_mask:0xf bank_mask:0xf\n\t" \
        "v_mul_f32_dpp %14, %16, %14 row_newbcast:14 row_mask:0xf bank_mask:0xf\n\t" \
        "v_mul_f32_dpp %15, %16, %15 row_newbcast:15 row_mask:0xf bank_mask:0xf\n\t" \
        "v_fmac_f32_dpp %0, %17, %18 row_newbcast:0 row_mask:0xf bank_mask:0xf\n\t" \
        "v_fmac_f32_dpp %1, %17, %18 row_newbcast:1 row_mask:0xf bank_mask:0xf\n\t" \
        "v_fmac_f32_dpp %2, %17, %18 row_newbcast:2 row_mask:0xf bank_mask:0xf\n\t" \
        "v_fmac_f32_dpp %3, %17, %18 row_newbcast:3 row_mask:0xf bank_mask:0xf\n\t" \
        "v_fmac_f32_dpp %4, %17, %18 row_newbcast:4 row_mask:0xf bank_mask:0xf\n\t" \
        "v_fmac_f32_dpp %5, %17, %18 row_newbcast:5 row_mask:0xf bank_mask:0xf\n\t" \
        "v_fmac_f32_dpp %6, %17, %18 row_newbcast:6 row_mask:0xf bank_mask:0xf\n\t" \
        "v_fmac_f32_dpp %7, %17, %18 row_newbcast:7 row_mask:0xf bank_mask:0xf\n\t" \
        "v_fmac_f32_dpp %8, %17, %18 row_newbcast:8 row_mask:0xf bank_mask:0xf\n\t" \
        "v_fmac_f32_dpp %9, %17, %18 row_newbcast:9 row_mask:0xf bank_mask:0xf\n\t" \
        "v_fmac_f32_dpp %10, %17, %18 row_newbcast:10 row_mask:0xf bank_mask:0xf\n\t" \
        "v_fmac_f32_dpp %11, %17, %18 row_newbcast:11 row_mask:0xf bank_mask:0xf\n\t" \
        "v_fmac_f32_dpp %12, %17, %18 row_newbcast:12 row_mask:0xf bank_mask:0xf\n\t" \
        "v_fmac_f32_dpp %13, %17, %18 row_newbcast:13 row_mask:0xf bank_mask:0xf\n\t" \
        "v_fmac_f32_dpp %14, %17, %18 row_newbcast:14 row_mask:0xf bank_mask:0xf\n\t" \
        "v_fmac_f32_dpp %15, %17, %18 row_newbcast:15 row_mask:0xf bank_mask:0xf\n\t" \
        "v_fmac_f32_dpp %0, %19, %20 row_newbcast:0 row_mask:0xf bank_mask:0xf\n\t" \
        "v_fmac_f32_dpp %1, %19, %20 row_newbcast:1 row_mask:0xf bank_mask:0xf\n\t" \
        "v_fmac_f32_dpp %2, %19, %20 row_newbcast:2 row_mask:0xf bank_mask:0xf\n\t" \
        "v_fmac_f32_dpp %3, %19, %20 row_newbcast:3 row_mask:0xf bank_mask:0xf\n\t" \
        "v_fmac_f32_dpp %4, %19, %20 row_newbcast:4 row_mask:0xf bank_mask:0xf\n\t" \
        "v_fmac_f32_dpp %5, %19, %20 row_newbcast:5 row_mask:0xf bank_mask:0xf\n\t" \
        "v_fmac_f32_dpp %6, %19, %20 row_newbcast:6 row_mask:0xf bank_mask:0xf\n\t" \
        "v_fmac_f32_dpp %7, %19, %20 row_newbcast:7 row_mask:0xf bank_mask:0xf\n\t" \
        "v_fmac_f32_dpp %8, %19, %20 row_newbcast:8 row_mask:0xf bank_mask:0xf\n\t" \
        "v_fmac_f32_dpp %9, %19, %20 row_newbcast:9 row_mask:0xf bank_mask:0xf\n\t" \
        "v_fmac_f32_dpp %10, %19, %20 row_newbcast:10 row_mask:0xf bank_mask:0xf\n\t" \
        "v_fmac_f32_dpp %11, %19, %20 row_newbcast:11 row_mask:0xf bank_mask:0xf\n\t" \
        "v_fmac_f32_dpp %12, %19, %20 row_newbcast:12 row_mask:0xf bank_mask:0xf\n\t" \
        "v_fmac_f32_dpp %13, %19, %20 row_newbcast:13 row_mask:0xf bank_mask:0xf\n\t" \
        "v_fmac_f32_dpp %14, %19, %20 row_newbcast:14 row_mask:0xf bank_mask:0xf\n\t" \
        "v_fmac_f32_dpp %15, %19, %20 row_newbcast:15 row_mask:0xf bank_mask:0xf\n\t" \
        : "+v"(S[(B)+0]), "+v"(S[(B)+1]), "+v"(S[(B)+2]), "+v"(S[(B)+3]), "+v"(S[(B)+4]), "+v"(S[(B)+5]), "+v"(S[(B)+6]), "+v"(S[(B)+7]), "+v"(S[(B)+8]), "+v"(S[(B)+9]), "+v"(S[(B)+10]), "+v"(S[(B)+11]), "+v"(S[(B)+12]), "+v"(S[(B)+13]), "+v"(S[(B)+14]), "+v"(S[(B)+15]) : "v"(wv), "v"(bv), "v"(sa), "v"(kv), "v"(vv))
#define SCAN_UPD16_Y(S, B, wv, bv, sa, kv, vv, rv, y0, y1) asm volatile( \
        "s_nop 1\n\t" \
        "v_mul_f32_dpp %0, %18, %0 row_newbcast:0 row_mask:0xf bank_mask:0xf\n\t" \
        "v_mul_f32_dpp %1, %18, %1 row_newbcast:1 row_mask:0xf bank_mask:0xf\n\t" \
        "v_mul_f32_dpp %2, %18, %2 row_newbcast:2 row_mask:0xf bank_mask:0xf\n\t" \
        "v_mul_f32_dpp %3, %18, %3 row_newbcast:3 row_mask:0xf bank_mask:0xf\n\t" \
        "v_mul_f32_dpp %4, %18, %4 row_newbcast:4 row_mask:0xf bank_mask:0xf\n\t" \
        "v_mul_f32_dpp %5, %18, %5 row_newbcast:5 row_mask:0xf bank_mask:0xf\n\t" \
        "v_mul_f32_dpp %6, %18, %6 row_newbcast:6 row_mask:0xf bank_mask:0xf\n\t" \
        "v_mul_f32_dpp %7, %18, %7 row_newbcast:7 row_mask:0xf bank_mask:0xf\n\t" \
        "v_mul_f32_dpp %8, %18, %8 row_newbcast:8 row_mask:0xf bank_mask:0xf\n\t" \
        "v_mul_f32_dpp %9, %18, %9 row_newbcast:9 row_mask:0xf bank_mask:0xf\n\t" \
        "v_mul_f32_dpp %10, %18, %10 row_newbcast:10 row_mask:0xf bank_mask:0xf\n\t" \
        "v_mul_f32_dpp %11, %18, %11 row_newbcast:11 row_mask:0xf bank_mask:0xf\n\t" \
        "v_mul_f32_dpp %12, %18, %12 row_newbcast:12 row_mask:0xf bank_mask:0xf\n\t" \
        "v_mul_f32_dpp %13, %18, %13 row_newbcast:13 row_mask:0xf bank_mask:0xf\n\t" \
        "v_mul_f32_dpp %14, %18, %14 row_newbcast:14 row_mask:0xf bank_mask:0xf\n\t" \
        "v_mul_f32_dpp %15, %18, %15 row_newbcast:15 row_mask:0xf bank_mask:0xf\n\t" \
        "v_fmac_f32_dpp %0, %19, %20 row_newbcast:0 row_mask:0xf bank_mask:0xf\n\t" \
        "v_fmac_f32_dpp %1, %19, %20 row_newbcast:1 row_mask:0xf bank_mask:0xf\n\t" \
        "v_fmac_f32_dpp %2, %19, %20 row_newbcast:2 row_mask:0xf bank_mask:0xf\n\t" \
        "v_fmac_f32_dpp %3, %19, %20 row_newbcast:3 row_mask:0xf bank_mask:0xf\n\t" \
        "v_fmac_f32_dpp %4, %19, %20 row_newbcast:4 row_mask:0xf bank_mask:0xf\n\t" \
        "v_fmac_f32_dpp %5, %19, %20 row_newbcast:5 row_mask:0xf bank_mask:0xf\n\t" \
        "v_fmac_f32_dpp %6, %19, %20 row_newbcast:6 row_mask:0xf bank_mask:0xf\n\t" \
        "v_fmac_f32_dpp %7, %19, %20 row_newbcast:7 row_mask:0xf bank_mask:0xf\n\t" \
        "v_fmac_f32_dpp %8, %19, %20 row_newbcast:8 row_mask:0xf bank_mask:0xf\n\t" \
        "v_fmac_f32_dpp %9, %19, %20 row_newbcast:9 row_mask:0xf bank_mask:0xf\n\t" \
        "v_fmac_f32_dpp %10, %19, %20 row_newbcast:10 row_mask:0xf bank_mask:0xf\n\t" \
        "v_fmac_f32_dpp %11, %19, %20 row_newbcast:11 row_mask:0xf bank_mask:0xf\n\t" \
        "v_fmac_f32_dpp %12, %19, %20 row_newbcast:12 row_mask:0xf bank_mask:0xf\n\t" \
        "v_fmac_f32_dpp %13, %19, %20 row_newbcast:13 row_mask:0xf bank_mask:0xf\n\t" \
        "v_fmac_f32_dpp %14, %19, %20 row_newbcast:14 row_mask:0xf bank_mask:0xf\n\t" \
        "v_fmac_f32_dpp %15, %19, %20 row_newbcast:15 row_mask:0xf bank_mask:0xf\n\t" \
        "v_fmac_f32_dpp %0, %21, %22 row_newbcast:0 row_mask:0xf bank_mask:0xf\n\t" \
        "v_fmac_f32_dpp %1, %21, %22 row_newbcast:1 row_mask:0xf bank_mask:0xf\n\t" \
        "v_fmac_f32_dpp %2, %21, %22 row_newbcast:2 row_mask:0xf bank_mask:0xf\n\t" \
        "v_fmac_f32_dpp %3, %21, %22 row_newbcast:3 row_mask:0xf bank_mask:0xf\n\t" \
        "v_fmac_f32_dpp %4, %21, %22 row_newbcast:4 row_mask:0xf bank_mask:0xf\n\t" \
        "v_fmac_f32_dpp %5, %21, %22 row_newbcast:5 row_mask:0xf bank_mask:0xf\n\t" \
        "v_fmac_f32_dpp %6, %21, %22 row_newbcast:6 row_mask:0xf bank_mask:0xf\n\t" \
        "v_fmac_f32_dpp %7, %21, %22 row_newbcast:7 row_mask:0xf bank_mask:0xf\n\t" \
        "v_fmac_f32_dpp %8, %21, %22 row_newbcast:8 row_mask:0xf bank_mask:0xf\n\t" \
        "v_fmac_f32_dpp %9, %21, %22 row_newbcast:9 row_mask:0xf bank_mask:0xf\n\t" \
        "v_fmac_f32_dpp %10, %21, %22 row_newbcast:10 row_mask:0xf bank_mask:0xf\n\t" \
        "v_fmac_f32_dpp %11, %21, %22 row_newbcast:11 row_mask:0xf bank_mask:0xf\n\t" \
        "v_fmac_f32_dpp %12, %21, %22 row_newbcast:12 row_mask:0xf bank_mask:0xf\n\t" \
        "v_fmac_f32_dpp %13, %21, %22 row_newbcast:13 row_mask:0xf bank_mask:0xf\n\t" \
        "v_fmac_f32_dpp %14, %21, %22 row_newbcast:14 row_mask:0xf bank_mask:0xf\n\t" \
        "v_fmac_f32_dpp %15, %21, %22 row_newbcast:15 row_mask:0xf bank_mask:0xf\n\t" \
        "v_fmac_f32_dpp %16, %23, %0 row_newbcast:0 row_mask:0xf bank_mask:0xf\n\t" \
        "v_fmac_f32_dpp %17, %23, %1 row_newbcast:1 row_mask:0xf bank_mask:0xf\n\t" \
        "v_fmac_f32_dpp %16, %23, %2 row_newbcast:2 row_mask:0xf bank_mask:0xf\n\t" \
        "v_fmac_f32_dpp %17, %23, %3 row_newbcast:3 row_mask:0xf bank_mask:0xf\n\t" \
        "v_fmac_f32_dpp %16, %23, %4 row_newbcast:4 row_mask:0xf bank_mask:0xf\n\t" \
        "v_fmac_f32_dpp %17, %23, %5 row_newbcast:5 row_mask:0xf bank_mask:0xf\n\t" \
        "v_fmac_f32_dpp %16, %23, %6 row_newbcast:6 row_mask:0xf bank_mask:0xf\n\t" \
        "v_fmac_f32_dpp %17, %23, %7 row_newbcast:7 row_mask:0xf bank_mask:0xf\n\t" \
        "v_fmac_f32_dpp %16, %23, %8 row_newbcast:8 row_mask:0xf bank_mask:0xf\n\t" \
        "v_fmac_f32_dpp %17, %23, %9 row_newbcast:9 row_mask:0xf bank_mask:0xf\n\t" \
        "v_fmac_f32_dpp %16, %23, %10 row_newbcast:10 row_mask:0xf bank_mask:0xf\n\t" \
        "v_fmac_f32_dpp %17, %23, %11 row_newbcast:11 row_mask:0xf bank_mask:0xf\n\t" \
        "v_fmac_f32_dpp %16, %23, %12 row_newbcast:12 row_mask:0xf bank_mask:0xf\n\t" \
        "v_fmac_f32_dpp %17, %23, %13 row_newbcast:13 row_mask:0xf bank_mask:0xf\n\t" \
        "v_fmac_f32_dpp %16, %23, %14 row_newbcast:14 row_mask:0xf bank_mask:0xf\n\t" \
        "v_fmac_f32_dpp %17, %23, %15 row_newbcast:15 row_mask:0xf bank_mask:0xf\n\t" \
        : "+v"(S[(B)+0]), "+v"(S[(B)+1]), "+v"(S[(B)+2]), "+v"(S[(B)+3]), "+v"(S[(B)+4]), "+v"(S[(B)+5]), "+v"(S[(B)+6]), "+v"(S[(B)+7]), "+v"(S[(B)+8]), "+v"(S[(B)+9]), "+v"(S[(B)+10]), "+v"(S[(B)+11]), "+v"(S[(B)+12]), "+v"(S[(B)+13]), "+v"(S[(B)+14]), "+v"(S[(B)+15]), "+v"(y0), "+v"(y1) : "v"(wv), "v"(bv), "v"(sa), "v"(kv), "v"(vv), "v"(rv))
constexpr int SCAN_D = 4;
template <int MODE>
__device__ __forceinline__ void scan_load(float (&buf)[5][4], const float* pa, const float* pw, const float* pb, const float* pk, const float* pr, size_t off) {
#pragma unroll
    for (int q = 0; q < 4; ++q) { buf[0][q] = pa[off + 16 * q]; buf[1][q] = pw[off + 16 * q]; buf[2][q] = pb[off + 16 * q];
        if (MODE >= 1) buf[3][q] = pk[off + 16 * q]; if (MODE == 2) buf[4][q] = pr[off + 16 * q]; }
}
template <int MODE>
__device__ __forceinline__ float scan_step(float (&S)[64], const float (&buf)[5][4], float v) {
    float s0 = 0.f, s1 = 0.f, s2 = 0.f, s3 = 0.f;
    SCAN_SA16(s0, s1, s2, s3, buf[0][0], S, 0); SCAN_SA16(s0, s1, s2, s3, buf[0][1], S, 16); SCAN_SA16(s0, s1, s2, s3, buf[0][2], S, 32); SCAN_SA16(s0, s1, s2, s3, buf[0][3], S, 48);
    const float sa = (s0 + s1) + (s2 + s3);
    if (MODE == 0) { SCAN_UPD16_P(S, 0, buf[1][0], buf[2][0], sa); SCAN_UPD16_P(S, 16, buf[1][1], buf[2][1], sa); SCAN_UPD16_P(S, 32, buf[1][2], buf[2][2], sa); SCAN_UPD16_P(S, 48, buf[1][3], buf[2][3], sa); return 0.f; }
    if (MODE == 1) { SCAN_UPD16_Q(S, 0, buf[1][0], buf[2][0], sa, buf[3][0], v); SCAN_UPD16_Q(S, 16, buf[1][1], buf[2][1], sa, buf[3][1], v); SCAN_UPD16_Q(S, 32, buf[1][2], buf[2][2], sa, buf[3][2], v); SCAN_UPD16_Q(S, 48, buf[1][3], buf[2][3], sa, buf[3][3], v); return 0.f; }
    float y0 = 0.f, y1 = 0.f;
    SCAN_UPD16_Y(S, 0, buf[1][0], buf[2][0], sa, buf[3][0], v, buf[4][0], y0, y1); SCAN_UPD16_Y(S, 16, buf[1][1], buf[2][1], sa, buf[3][1], v, buf[4][1], y0, y1);
    SCAN_UPD16_Y(S, 32, buf[1][2], buf[2][2], sa, buf[3][2], v, buf[4][2], y0, y1); SCAN_UPD16_Y(S, 48, buf[1][3], buf[2][3], sa, buf[3][3], v, buf[4][3], y0, y1);
    return y0 + y1;
}

constexpr int P1_D = 8, P1_SLOT = 1280;
#define PIN8(arr) asm volatile("" : "+v"(arr[0]), "+v"(arr[1]), "+v"(arr[2]), "+v"(arr[3]), "+v"(arr[4]), "+v"(arr[5]), "+v"(arr[6]), "+v"(arr[7]))
#define PIN6(arr) asm volatile("" : "+v"(arr[0]), "+v"(arr[1]), "+v"(arr[2]), "+v"(arr[3]), "+v"(arr[4]), "+v"(arr[5]))
typedef float f32x32 __attribute__((ext_vector_type(32)));
typedef float f32x16 __attribute__((ext_vector_type(16)));
#define P1_RS2(s0, s1) asm volatile("s_nop 1\n\tv_permlane32_swap_b32 %0, %1\n\tv_add_f32 %0, %0, %1\n\ts_nop 4" : "+v"(s0), "+v"(s1))
__device__ __forceinline__ void p6_item(unsigned char* ws, const float* dout, LAS unsigned char* ring, int bh, int seg, int lane) {
    asm volatile("" : "+v"(lane));
    const float* Vi = dout; const float* Ai = dout + (size_t)M * DR;
    const int b = bh >> 5, h = bh & 31;
    const size_t base = ((size_t)b * T + (size_t)seg * SEGLEN) * DR + h * HD;
    const float* gsrc = (lane < 16 ? Ai : lane < 32 ? (const float*)(ws + WS_BV) : lane < 48 ? (const float*)(ws + WS_KK) : (const float*)(ws + WS_R)) + base + (lane & 15) * 4;
    const bf16* vsrc = (const bf16*)Vi + ((size_t)bh * T + (size_t)seg * SEGLEN) * 64 + lane * 8;        const float* cesrc = (const float*)(ws + WS_CEND) + ((size_t)b * (T / 64) + (size_t)seg * (SEGLEN / 64)) * DR + h * HD + lane;
    const size_t ibase = (size_t)(bh * NSEG + seg) * (SEGLEN * 64);
    unsigned* pqo = (unsigned*)(ws + WS_PQ) + ibase + lane;
    const int c = lane & 31, hh = lane >> 5;
    f32x32 SP[2]; f32x16 SQ[2][2];
#pragma unroll
    for (int jb = 0; jb < 2; ++jb)
#pragma unroll
        for (int x = 0; x < 32; ++x) { const int ib = x >> 4, q = (x >> 2) & 3, e2 = x & 3; SP[jb][x] = (32 * jb + 8 * q + 4 * hh + e2 == 32 * ib + c) ? 1.f : 0.f; SQ[jb][ib][x & 15] = 0.f; }
    const unsigned rbase = (unsigned)(size_t)ring, vaddr = rbase + (unsigned)lane * 2u, caddr = rbase + (unsigned)c * 4u, haddr = rbase + (unsigned)hh * 16u, kaddr = caddr + (unsigned)hh * 256u;
    asm volatile("s_waitcnt vmcnt(0)" ::: "memory");
    __builtin_amdgcn_global_load_lds((const unsigned*)cesrc, (LAS unsigned*)(ring + P1_D * P1_SLOT), 4, 0, 0);
    constexpr int VBASE = P1_D * P1_SLOT + 256;
    __builtin_amdgcn_global_load_lds((const unsigned*)vsrc, (LAS unsigned*)(ring + VBASE), 16, 0, 0);
    __builtin_amdgcn_global_load_lds((const unsigned*)(vsrc + 8 * 64), (LAS unsigned*)(ring + VBASE + 1024), 16, 0, 0);
#pragma unroll
    for (int d = 0; d < P1_D; ++d) __builtin_amdgcn_global_load_lds((const unsigned*)(gsrc + (size_t)d * DR), (LAS unsigned*)(ring + d * P1_SLOT), 16, 0, 0);
    f32x4 X[8]; float bb[2], kk[2]; unsigned vv;
#define LDX(SL, VOFF) asm volatile("ds_read_b128 %0, %8 offset:%9\n\tds_read_b128 %1, %8 offset:%10\n\tds_read_b128 %2, %8 offset:%11\n\tds_read_b128 %3, %8 offset:%12\n\t" \
                                   "ds_read_b128 %4, %8 offset:%13\n\tds_read_b128 %5, %8 offset:%14\n\tds_read_b128 %6, %8 offset:%15\n\tds_read_b128 %7, %8 offset:%16" \
        : "=&v"(X[0]), "=&v"(X[1]), "=&v"(X[2]), "=&v"(X[3]), "=&v"(X[4]), "=&v"(X[5]), "=&v"(X[6]), "=&v"(X[7]) : "v"(haddr), \
          "n"((SL) * P1_SLOT + (VOFF)), "n"((SL) * P1_SLOT + (VOFF) + 32), "n"((SL) * P1_SLOT + (VOFF) + 64), "n"((SL) * P1_SLOT + (VOFF) + 96), \
          "n"((SL) * P1_SLOT + (VOFF) + 128), "n"((SL) * P1_SLOT + (VOFF) + 160), "n"((SL) * P1_SLOT + (VOFF) + 192), "n"((SL) * P1_SLOT + (VOFF) + 224))
#define LDBKV(SL, VA) asm volatile("ds_read_b32 %0, %5 offset:%8\n\tds_read_b32 %1, %5 offset:%9\n\tds_read_b32 %2, %6 offset:%8\n\tds_read_b32 %3, %6 offset:%9\n\tds_read_u16 %4, %7 offset:%10" \
        : "=&v"(bb[0]), "=&v"(bb[1]), "=&v"(kk[0]), "=&v"(kk[1]), "=&v"(vv) : "v"(caddr), "v"(kaddr), "v"(VA), "n"((SL) * P1_SLOT + 256), "n"((SL) * P1_SLOT + 256 + 128), "n"(VBASE + (SL) * 128))
#define WX(N) asm volatile("s_waitcnt lgkmcnt(%8)" : "+v"(X[0]), "+v"(X[1]), "+v"(X[2]), "+v"(X[3]), "+v"(X[4]), "+v"(X[5]), "+v"(X[6]), "+v"(X[7]) : "n"(N))
#define DOTS(o0, o1, u0, u1) do { f32x2 a0 = {0.f, 0.f}, a1 = a0, c0 = a0, c1 = a0; \
        _Pragma("unroll") for (int jb = 0; jb < 2; ++jb) _Pragma("unroll") for (int q = 0; q < 4; ++q) { const f32x4 xq = X[4 * jb + q]; const f32x2 lo = {xq.x, xq.y}, hi = {xq.z, xq.w}; \
            a0 = __builtin_elementwise_fma((f32x2){SP[jb][4 * q], SP[jb][4 * q + 1]}, lo, a0); a0 = __builtin_elementwise_fma((f32x2){SP[jb][4 * q + 2], SP[jb][4 * q + 3]}, hi, a0); \
            a1 = __builtin_elementwise_fma((f32x2){SP[jb][16 + 4 * q], SP[jb][16 + 4 * q + 1]}, lo, a1); a1 = __builtin_elementwise_fma((f32x2){SP[jb][16 + 4 * q + 2], SP[jb][16 + 4 * q + 3]}, hi, a1); \
            c0 = __builtin_elementwise_fma((f32x2){SQ[jb][0][4 * q], SQ[jb][0][4 * q + 1]}, lo, c0); c0 = __builtin_elementwise_fma((f32x2){SQ[jb][0][4 * q + 2], SQ[jb][0][4 * q + 3]}, hi, c0); \
            c1 = __builtin_elementwise_fma((f32x2){SQ[jb][1][4 * q], SQ[jb][1][4 * q + 1]}, lo, c1); c1 = __builtin_elementwise_fma((f32x2){SQ[jb][1][4 * q + 2], SQ[jb][1][4 * q + 3]}, hi, c1); } \
        o0 = a0.x + a0.y; o1 = a1.x + a1.y; u0 = c0.x + c0.y; u1 = c1.x + c1.y; } while (0)
    asm volatile("s_waitcnt vmcnt(%0)" :: "n"(P1_D - 1) : "memory");
    LDX(0, 0); LDBKV(0, vaddr);
    for (int t0 = 0; t0 < SEGLEN; t0 += P1_D) {
        const unsigned vh = vaddr + ((t0 & 8) ? 1024u : 0u), vhn = vaddr + ((t0 & 8) ? 0u : 1024u);
#pragma unroll
        for (int d = 0; d < P1_D; ++d) {
            constexpr int PD2 = P1_D - 2;
            constexpr int W0[8] = {6, 7, 8, 9, 10, 11, 12, 12}, W1[8] = {13, 13, 13, 13, 13, 13, 13, 12};
            if (t0 == 0) asm volatile("s_waitcnt vmcnt(%0)" :: "n"(W0[d]) : "memory");
            else asm volatile("s_waitcnt vmcnt(%0)" :: "n"(W1[d]) : "memory");
            const int sn = (d + 1) % P1_D;
            asm volatile("s_waitcnt lgkmcnt(0)" : "+v"(X[0]), "+v"(X[1]), "+v"(X[2]), "+v"(X[3]), "+v"(X[4]), "+v"(X[5]), "+v"(X[6]), "+v"(X[7]), "+v"(bb[0]), "+v"(bb[1]), "+v"(kk[0]), "+v"(kk[1]), "+v"(vv));
            float sP0, sP1, sQ0, sQ1;
            DOTS(sP0, sP1, sQ0, sQ1);
            asm volatile("" : "+v"(sP0), "+v"(sP1), "+v"(sQ0), "+v"(sQ1));
            LDX(d, 768);
            P1_RS2(sP0, sP1); P1_RS2(sQ0, sQ1);
            float bq0 = sQ0, bq1 = __builtin_bit_cast(float, vv << 16);
            asm volatile("s_nop 1\n\tv_permlane32_swap_b32 %0, %1\n\ts_nop 4" : "+v"(bq0), "+v"(bq1));
#pragma unroll
            for (int jb = 0; jb < 2; ++jb) {
                SP[jb] = __builtin_amdgcn_mfma_f32_32x32x1f32(bb[jb], sP0, SP[jb], 0, 0, 0);
                SQ[jb][0] = __builtin_amdgcn_mfma_f32_32x32x2f32(kk[jb], bq0, SQ[jb][0], 0, 0, 0);
                SQ[jb][1] = __builtin_amdgcn_mfma_f32_32x32x2f32(kk[jb], bq1, SQ[jb][1], 0, 0, 0); }
            WX(0);
            float dP0, dP1, dQ0, dQ1;
            DOTS(dP0, dP1, dQ0, dQ1);
            asm volatile("" : "+v"(dP0), "+v"(dP1), "+v"(dQ0), "+v"(dQ1));
            LDX(sn, 0); if (d < P1_D - 1) LDBKV(sn, vh); else LDBKV(sn, vhn);
            P1_RS2(dP0, dP1); P1_RS2(dQ0, dQ1);
            const int tn = (t0 + d + P1_D < SEGLEN) ? t0 + d + P1_D : SEGLEN - 1;
            { unsigned w; asm volatile("v_cvt_pk_bf16_f32 %0, %1, %2" : "=v"(w) : "v"(dP0), "v"(dQ0)); pqo[(size_t)(t0 + d) * 64] = w; }
            if (d == P1_D - 1 && ((t0 + d) & 63) == 63) {
                f32x4 cq[8];
                asm volatile("s_waitcnt lgkmcnt(0)" : "+v"(X[0]), "+v"(X[1]), "+v"(X[2]), "+v"(X[3]), "+v"(X[4]), "+v"(X[5]), "+v"(X[6]), "+v"(X[7]), "+v"(bb[0]), "+v"(bb[1]), "+v"(kk[0]), "+v"(kk[1]), "+v"(vv));
#pragma unroll
                for (int x = 0; x < 8; ++x) asm volatile("ds_read_b128 %0, %1 offset:%2" : "=v"(cq[x]) : "v"(haddr), "n"(P1_D * P1_SLOT + 32 * x));
                asm volatile("s_waitcnt lgkmcnt(0)" : "+v"(cq[0]), "+v"(cq[1]), "+v"(cq[2]), "+v"(cq[3]), "+v"(cq[4]), "+v"(cq[5]), "+v"(cq[6]), "+v"(cq[7]));
#pragma unroll
                for (int jb = 0; jb < 2; ++jb)
#pragma unroll
                    for (int x = 0; x < 32; ++x) { const int q = (x >> 2) & 3, e2 = x & 3; const float cv = cq[4 * jb + q][e2]; SP[jb][x] *= cv; SQ[jb][x >> 4][x & 15] *= cv; }
                if (t0 + d + 1 < SEGLEN) __builtin_amdgcn_global_load_lds((const unsigned*)(cesrc + (size_t)((t0 + d + 1) >> 6) * DR), (LAS unsigned*)(ring + P1_D * P1_SLOT), 4, 0, 0);
            }
            __builtin_amdgcn_global_load_lds((const unsigned*)(gsrc + (size_t)tn * DR), (LAS unsigned*)(ring + d * P1_SLOT), 16, 0, 0);
            if (d == P1_D - 1) { const int tv = (t0 + d + 9 <= SEGLEN - 8) ? t0 + d + 9 : SEGLEN - 8;
                __builtin_amdgcn_global_load_lds((const unsigned*)(vsrc + (size_t)tv * 64), (LAS unsigned*)(ring + VBASE + ((t0 & 8) ? 1024 : 0)), 16, 0, 0); }
        }
    }
    asm volatile("s_waitcnt lgkmcnt(0)" : "+v"(X[0]), "+v"(X[1]), "+v"(X[2]), "+v"(X[3]), "+v"(X[4]), "+v"(X[5]), "+v"(X[6]), "+v"(X[7]), "+v"(bb[0]), "+v"(bb[1]), "+v"(kk[0]), "+v"(kk[1]), "+v"(vv));
#undef LDX
#undef LDBKV
#undef WX
#undef DOTS
    int lane2 = lane; asm volatile("" : "+v"(lane2));
    const int c2 = lane2 & 31, h2 = lane2 >> 5;
    float* dp = (float*)(ws + WS_PBUF) + (size_t)(bh * NSEG + seg) * 4096 + c2 * 64 + h2 * 4; float* dq = (float*)(ws + WS_QBUF) + (size_t)(bh * NSEG + seg) * 4096 + c2 * 64 + h2 * 4;
#pragma unroll
    for (int jb = 0; jb < 2; ++jb)
#pragma unroll
        for (int ib = 0; ib < 2; ++ib)
#pragma unroll
            for (int q = 0; q < 4; ++q) { const int x = 16 * ib + 4 * q;
                *(f32x4*)(dp + ib * 2048 + jb * 32 + q * 8) = (f32x4){SP[jb][x], SP[jb][x + 1], SP[jb][x + 2], SP[jb][x + 3]};
                *(f32x4*)(dq + ib * 2048 + jb * 32 + q * 8) = (f32x4){SQ[jb][ib][4 * q], SQ[jb][ib][4 * q + 1], SQ[jb][ib][4 * q + 2], SQ[jb][ib][4 * q + 3]}; }
}
__device__ __forceinline__ void p6_scan_pass1(unsigned char* ws, const float* dout, LAS unsigned char* lds, int wave, int lane) {
    LAS unsigned char* ring = lds + wave * (P1_D * P1_SLOT + 256 + 2048);
    for (int pi = blockIdx.x * NWAVES + wave; pi < 64 * NSEG; pi += gridDim.x * NWAVES) {
        const int bh = pi >> 5, seg = pi & 31;
        p6_item(ws, dout, ring, bh, seg, lane);
    }
    asm volatile("s_waitcnt vmcnt(0)" ::: "memory");
}

__device__ __forceinline__ void p7_combine(unsigned char* ws, LAS unsigned char* lds, int tid) {
    LAS float* Sl = (LAS float*)lds;
    LAS float* Pl = (LAS float*)(lds + 4160);
    const int il = tid >> 5, jq = tid & 31, pi = tid >> 3, pj = tid & 7;
    for (int it = blockIdx.x; it < 64 * 4; it += gridDim.x) {
        const int bh = it >> 2, i = (it & 3) * 16 + il;
        float S0 = 0.f, S1 = 0.f;
        for (int seg = 0; seg < NSEG; ++seg) {
            const size_t mo = ((size_t)(bh * NSEG + seg) * 64 + i) * 64 + jq * 2;
            *(f32x2*)((float*)(ws + WS_SST) + mo) = (f32x2){S0, S1};
            if (seg == NSEG - 1) break;
            const float* pp = (const float*)(ws + WS_PBUF) + ((size_t)(bh * NSEG + seg) * 64 + pi) * 64 + pj * 8;
            const f32x4 p0 = *(const f32x4*)pp, p1 = *(const f32x4*)(pp + 4); const f32x2 q = *(const f32x2*)((const float*)(ws + WS_QBUF) + mo);
            __syncthreads();
            *(LAS f32x4*)(Pl + pi * 64 + pj * 8) = p0; *(LAS f32x4*)(Pl + pi * 64 + pj * 8 + 4) = p1;
            Sl[il * 65 + jq * 2] = S0; Sl[il * 65 + jq * 2 + 1] = S1;
            __syncthreads();
            float a0 = q.x, a1 = q.y, b0 = 0.f, b1 = 0.f;
#pragma unroll 8
            for (int mm = 0; mm < 64; mm += 2) { const float s0 = Sl[il * 65 + mm], s1 = Sl[il * 65 + mm + 1]; const f32x2 pa = *(const LAS f32x2*)(Pl + mm * 64 + jq * 2), pb = *(const LAS f32x2*)(Pl + (mm + 1) * 64 + jq * 2);
                a0 += s0 * pa.x; a1 += s0 * pa.y; b0 += s1 * pb.x; b1 += s1 * pb.y; }
            S0 = a0 + b0; S1 = a1 + b1;
        }
        __syncthreads();
    }
}

__device__ __forceinline__ void p8_scan_pass3(const float* lnx_w, const float* lnx_b, unsigned char* ws, const float* dout, LAS unsigned char* sl, int gw, int NGW, int lane) {
    const float* Vi = dout;
    const bf16* G = (const bf16*)(ws + WS_G); const float* BON = (const float*)(ws + WS_BONUS); bf16* O = (bf16*)(ws + WS_OCB);
    const int n = lane & 15, g4 = (lane >> 4) * 4;
    LAS f32x4* sa = (LAS f32x4*)sl + lane;
    for (int item = gw; item < 64 * NSEG; item += NGW) {
        const int h = item & 31, seg = (item >> 5) & 31, b = item >> 10, bh = b * 32 + h;
        const size_t row0 = (size_t)b * T + (size_t)seg * SEGLEN + n;
        const size_t base = row0 * DR + h * HD + g4;
        { const float* sp = (const float*)(ws + WS_SST) + (size_t)(bh * NSEG + seg) * 4096 + g4;
#pragma unroll
          for (int mt = 0; mt < 4; ++mt)
#pragma unroll
              for (int c = 0; c < 4; ++c) sa[(mt * 4 + c) * 64] = *(const f32x4*)(sp + (16 * mt + n) * 64 + 16 * c); }
        asm volatile("" ::: "memory");
        f32x4 lw[4], lb[4];
#pragma unroll
        for (int mt = 0; mt < 4; ++mt) { lw[mt] = *(const f32x4*)(lnx_w + h * HD + 16 * mt + g4); lb[mt] = *(const f32x4*)(lnx_b + h * HD + 16 * mt + g4); }
        const size_t ibase = (size_t)(bh * NSEG + seg) * (SEGLEN * 64) + n * 64 + g4;
        const unsigned* pq = (const unsigned*)(ws + WS_PQ) + ibase; const bf16* vp = (const bf16*)Vi + ((size_t)bh * T + (size_t)seg * SEGLEN + n) * 64 + g4; const bf16* gp = G + base;
        const float* bp = BON + row0 * NH + h; bf16* op = O + row0 * D + h * HD + g4;
        v4u npq[4]; v2u nv[4]; v2u ng[4]; float nbo;
#define P9_LOAD(BLK) do { const size_t ro = (size_t)(BLK) * 16 * DR, ri = (size_t)(BLK) * 16 * 64; \
            _Pragma("unroll") for (int q = 0; q < 4; ++q) { npq[q] = __builtin_nontemporal_load((const GAS v4u*)(pq + ri + 16 * q)); \
                nv[q] = __builtin_nontemporal_load((const GAS v2u*)(vp + ri + 16 * q)); ng[q] = __builtin_nontemporal_load((const GAS v2u*)(gp + ro + 16 * q)); } \
            nbo = bp[(size_t)(BLK) * 16 * NH]; } while (0)
        P9_LOAD(0);
#pragma unroll 1
        for (int blk = 0; blk < SEGLEN / 16; ++blk) {
            f32x4 pb[4], acc[4], vv[4]; v2u gg[4];
#pragma unroll
            for (int q = 0; q < 4; ++q) { const v4u w = npq[q]; pb[q] = (f32x4){bflo(w.x), bflo(w.y), bflo(w.z), bflo(w.w)}; acc[q] = (f32x4){bfhi(w.x), bfhi(w.y), bfhi(w.z), bfhi(w.w)}; vv[q] = (f32x4){bflo(nv[q].x), bfhi(nv[q].x), bflo(nv[q].y), bfhi(nv[q].y)}; gg[q] = ng[q]; }
            const float bo = nbo;
            { const int bn = blk + 1 < SEGLEN / 16 ? blk + 1 : blk; P9_LOAD(bn); }
#pragma unroll
            for (int c = 0; c < 4; ++c) {
                f32x4 a[4];
#pragma unroll
                for (int mt = 0; mt < 4; ++mt) a[mt] = sa[(mt * 4 + c) * 64];
#pragma unroll
                for (int r = 0; r < 4; ++r)
#pragma unroll
                    for (int mt = 0; mt < 4; ++mt) acc[mt] = __builtin_amdgcn_mfma_f32_16x16x4f32(a[mt][r], pb[c][r], acc[mt], 0, 0, 0);
                if (c & 1) asm volatile("" ::: "memory");
            }
            float s1 = 0.f, s2 = 0.f;
#pragma unroll
            for (int mt = 0; mt < 4; ++mt) { s1 += (acc[mt].x + acc[mt].y) + (acc[mt].z + acc[mt].w); s2 += (acc[mt].x * acc[mt].x + acc[mt].y * acc[mt].y) + (acc[mt].z * acc[mt].z + acc[mt].w * acc[mt].w); }
            s1 += __shfl_xor(s1, 16); s2 += __shfl_xor(s2, 16); s1 += __shfl_xor(s1, 32); s2 += __shfl_xor(s2, 32);
            const float mean = s1 * (1.0f / 64.0f), var = fmaxf(s2 * (1.0f / 64.0f) - mean * mean, 0.f), rstd = __builtin_amdgcn_rsqf(var + LNX_EPS);
            bf16* orow = op + (size_t)blk * 16 * D;
#pragma unroll
            for (int mt = 0; mt < 4; ++mt) {
                const f32x4 yn = (acc[mt] - mean) * rstd * lw[mt] + lb[mt];
                const f32x4 gf = {bflo(gg[mt].x), bfhi(gg[mt].x), bflo(gg[mt].y), bfhi(gg[mt].y)};
                const f32x4 o = (yn + vv[mt] * bo) * gf;
                v2u w; w.x = pk2(o.x, o.y); w.y = pk2(o.z, o.w);
                *(GAS v2u*)(orow + 16 * mt) = w;
            }
        }
#undef P9_LOAD
    }
}

__device__ __forceinline__ void p15_act_fixup(const float* convw, unsigned char* ws, int gt, int NT) {
    const bf16* HG0 = (const bf16*)(ws + WS_HG0); const bf16* HV0 = (const bf16*)(ws + WS_HV0); const bf16* HG1 = (const bf16*)(ws + WS_HG1); bf16* ACT = (bf16*)(ws + WS_ACT);
    constexpr int NC8 = FF / 8;
    for (int e = gt; e < 256 * 2 * NC8; e += NT) {
        const int c8 = e % NC8, rr = (e / NC8) & 1, blk = e / (2 * NC8), c = c8 * 8;
        const bool first = (blk % (T / 64)) == 0;
        const v4u z = {0u, 0u, 0u, 0u};
        const v4u g0 = *(const GAS v4u*)(HG0 + ((size_t)blk * 2 + rr) * FF + c), vv = *(const GAS v4u*)(HV0 + ((size_t)blk * 2 + rr) * FF + c);
        const v4u p63 = first ? z : *(const GAS v4u*)(HG1 + ((size_t)(blk - 1) * 2 + 1) * FF + c), p62 = first ? z : *(const GAS v4u*)(HG1 + ((size_t)(blk - 1) * 2 + 0) * FF + c);
        const v4u g1 = rr ? *(const GAS v4u*)(HG0 + ((size_t)blk * 2 + 0) * FF + c) : p63;
        const v4u g2 = rr ? p63 : p62;
        const f32x4 wa0 = *(const f32x4*)(convw + c), wa1 = *(const f32x4*)(convw + c + 4), wb0 = *(const f32x4*)(convw + FF + c), wb1 = *(const f32x4*)(convw + FF + c + 4), wc0 = *(const f32x4*)(convw + 2 * FF + c), wc1 = *(const f32x4*)(convw + 2 * FF + c + 4);
        float y[8];
        y[0] = wa0.x * bflo(g2.x) + wb0.x * bflo(g1.x) + wc0.x * bflo(g0.x); y[1] = wa0.y * bfhi(g2.x) + wb0.y * bfhi(g1.x) + wc0.y * bfhi(g0.x);
        y[2] = wa0.z * bflo(g2.y) + wb0.z * bflo(g1.y) + wc0.z * bflo(g0.y); y[3] = wa0.w * bfhi(g2.y) + wb0.w * bfhi(g1.y) + wc0.w * bfhi(g0.y);
        y[4] = wa1.x * bflo(g2.z) + wb1.x * bflo(g1.z) + wc1.x * bflo(g0.z); y[5] = wa1.y * bfhi(g2.z) + wb1.y * bfhi(g1.z) + wc1.y * bfhi(g0.z);
        y[6] = wa1.z * bflo(g2.w) + wb1.z * bflo(g1.w) + wc1.z * bflo(g0.w); y[7] = wa1.w * bfhi(g2.w) + wb1.w * bfhi(g1.w) + wc1.w * bfhi(g0.w);
        const float vl[8] = {bflo(vv.x), bfhi(vv.x), bflo(vv.y), bfhi(vv.y), bflo(vv.z), bfhi(vv.z), bflo(vv.w), bfhi(vv.w)};
        float o[8];
#pragma unroll
        for (int q = 0; q < 8; ++q) o[q] = y[q] * sigm(y[q]) * vl[q];
        v4u ov; ov.x = pk2(o[0], o[1]); ov.y = pk2(o[2], o[3]); ov.z = pk2(o[4], o[5]); ov.w = pk2(o[6], o[7]);
        *(GAS v4u*)(ACT + ((size_t)blk * 64 + rr) * FF + c) = ov;
    }
}

constexpr int N_PHASES = 17;
struct Args { const float* in[26]; float* out; unsigned char* ws; int ph_lo, ph_hi, li, pad; };
__global__ void __launch_bounds__(NWAVES * 64, 2) mk_fwd(Args args) {
    extern __shared__ __attribute__((aligned(16))) unsigned char lds_raw[];
    LAS unsigned char* lds = (LAS unsigned char*)lds_raw;
    volatile LAS unsigned* MISC = (volatile LAS unsigned*)(lds + MISC_OFF);
    const int tid = threadIdx.x, lane = tid & 63, wave = __builtin_amdgcn_readfirstlane(tid >> 6);
    const int G = gridDim.x, gw = blockIdx.x * NWAVES + wave, NGW = G * NWAVES, gt = gw * 64 + lane, NT = NGW * 64;
    unsigned char* ws = args.ws; float* dout = args.out;
    gu32* ctl = (gu32*)(ws + WS_CTL);
    for (int u = tid; u < (LDS_BYTES - LDSCTL_OFF) / 4; u += NWAVES * 64) ((LAS unsigned*)(lds + LDSCTL_OFF))[u] = 0u;
    __syncthreads();
    XcdBarrier bar; bar.bar = (unsigned*)(ctl + CW_BAR) + args.li * XCD_BAR_WORDS; bar.x = 0; bar.st = nullptr;
    if (MK_N_LAUNCHES == 1) bar = xcd_barrier_post((unsigned*)(ctl + CW_BAR), MISC + 8);
    const int lo = args.ph_lo, hi = args.ph_hi;
#define IN(k) (lo <= (k) && (k) < hi)
#define SEAM(k) do { if (IN(k) && IN((k) + 1)) xcd_barrier(bar); } while (0)
    const float* MOD = (const float*)(ws + WS_MOD);

    if (IN(0)) { p0_prologue(args.in, ws, lds, gw, NGW, tid, lane, wave); }
    if (IN(0) && IN(2)) xcd_barrier(bar);
    if (IN(2)) { norm_mod_rows<false>(args.in[0], nullptr, args.in[4], MOD, 0, D, (bf16*)(ws + WS_H), lds, gw, NGW, tid, lane); }
    SEAM(2);
    if (IN(3)) {
        pg8::Gemm g{(const pg8::bf16_t*)(ws + WS_H), (const pg8::bf16_t*)(ws + WS_WIN), M, N_INP, D, 1 << 30, 0}; pg8::StaticOrder S; S.init(M, N_INP, G, (int)blockIdx.x);
        pg8::EpiProj E{(pg8::bf16_t*)(ws + WS_PS), (pg8::bf16_t*)(ws + WS_PC), (pg8::bf16_t*)(ws + WS_PG)};
        pg8::gemm_phase<pg8::EpiProj, pg8::StaticOrder, PG8_ALIGN, PG8_SP2>(lds + RING_OFF, g, S, E);
    }
    SEAM(3);
    if (IN(4)) { p3_prep(args.in[6], args.in[17], ws, gw, NGW, lane); }
    SEAM(4);
    if (IN(5)) {
        pg8::Gemm g{(const pg8::bf16_t*)(ws + WS_ALORA), (const pg8::bf16_t*)(ws + WS_WLORA), M, 3 * DR, 256, 8, (size_t)M * 256 * 2}; pg8::StaticOrder S; S.init(M, 3 * DR, G, (int)blockIdx.x);
        pg8::EpiLora E{(float*)(ws + WS_WD), (pg8::bf16_t*)(ws + WS_ICLR), (pg8::bf16_t*)(ws + WS_G), args.in[7], args.in[8]};
        pg8::gemm_phase<pg8::EpiLora, pg8::StaticOrder, PG8_ALIGN, PG8_SP2, 16>(lds + RING_OFF, g, S, E);
    }
    SEAM(5);
    if (IN(6)) { p5_scanprep(args.in[6], args.in[9], args.in[10], args.in[11], ws, dout, gw, NGW, lane); }
    SEAM(6);
    if (IN(7)) { p6_scan_pass1(ws, dout, lds, wave, lane); }
    SEAM(7);
    if (IN(8)) { p7_combine(ws, lds, tid); }
    SEAM(8);
    if (IN(9)) { p8_scan_pass3(args.in[15], args.in[16], ws, dout, lds + wave * 16384, gw, NGW, lane); }
    SEAM(9);
    if (IN(10)) {
        pg8::Gemm g{(const pg8::bf16_t*)(ws + WS_OCB), (const pg8::bf16_t*)(ws + WS_WOCAT), M, D, D, 1 << 30, 0}; pg8::StaticOrder S; S.init(M, D, G, (int)blockIdx.x);
        pg8::EpiMix E{(const pg8::bf16_t*)(ws + WS_PG), (pg8::bf16_t*)(ws + WS_MERGED)};
        pg8::gemm_phase<pg8::EpiMix, pg8::StaticOrder, PG8_ALIGN, PG8_SP2>(lds + RING_OFF, g, S, E);
    }
    if (IN(10) && IN(12)) xcd_barrier(bar);
    if (IN(12)) {
        pg8::Gemm g{(const pg8::bf16_t*)(ws + WS_MERGED), (const pg8::bf16_t*)(ws + WS_WOUT), M, D, D, 1 << 30, 0}; pg8::StaticOrder S; S.init(M, D, G, (int)blockIdx.x);
        pg8::EpiDelta E{(pg8::bf16_t*)(ws + WS_D1), MOD + 2 * D};
        pg8::gemm_phase<pg8::EpiDelta, pg8::StaticOrder, PG8_ALIGN, PG8_SP2>(lds + RING_OFF, g, S, E);
    }
    SEAM(12);
    if (IN(13)) {
        norm_mod_rows<true>(args.in[0], (const bf16*)(ws + WS_D1), args.in[21], MOD, 3 * D, 4 * D, (bf16*)(ws + WS_H2), lds, gw, NGW, tid, lane);
        LAS unsigned* scr = (LAS unsigned*)(lds + 32768 + wave * 8320);
        constexpr int I_UP = 64 * 344, I_DN = 172 * 64;
        for (int it = gw; it < I_UP + I_DN; it += NGW) {
            if (it < I_UP) { const int nb = it % 344, n0 = nb * 64, isv = n0 >= FF ? 1 : 0, c0 = n0 - isv * FF;
                transpose_item(args.in[22], NUP, D, (bf16*)(ws + WS_WUP), it / 344, nb, (c0 >> 7) * 256 + (c0 & 127) + isv * 128, scr, lane); }
            else { const int r = it - I_UP; transpose_item(args.in[24], D, FF, (bf16*)(ws + WS_WDOWN), r / 64, r % 64, (r % 64) * 64, scr, lane); }
        }
    }
    SEAM(13);
    if (IN(14)) {
        pg8::Gemm g{(const pg8::bf16_t*)(ws + WS_H2), (const pg8::bf16_t*)(ws + WS_WUP), M, NUP, D, 1 << 30, 0}; pg8::StaticOrder S; S.init(M, NUP, G, (int)blockIdx.x);
        pg8::EpiAct E{(pg8::bf16_t*)(ws + WS_ACT), args.in[23], (pg8::bf16_t*)(ws + WS_HG0), (pg8::bf16_t*)(ws + WS_HV0), (pg8::bf16_t*)(ws + WS_HG1)};
        pg8::gemm_phase<pg8::EpiAct, pg8::StaticOrder, PG8_ALIGN, PG8_SP2>(lds + RING_OFF, g, S, E);
    }
    SEAM(14);
    if (IN(15)) { p15_act_fixup(args.in[23], ws, gt, NT); }
    SEAM(15);
    if (IN(16)) {
        pg8::Gemm g{(const pg8::bf16_t*)(ws + WS_ACT), (const pg8::bf16_t*)(ws + WS_WDOWN), M, D, FF, 1 << 30, 0}; pg8::StaticOrder S; S.init(M, D, G, (int)blockIdx.x);
        pg8::EpiDeltaSum E{(pg8::bf16_t*)(ws + WS_D2), MOD + 5 * D, (const pg8::bf16_t*)(ws + WS_D1)};
        pg8::gemm_phase<pg8::EpiDeltaSum, pg8::StaticOrder, PG8_ALIGN, PG8_SP2>(lds + RING_OFF, g, S, E);
    }
    SEAM(16);
    if (IN(17)) { const int l17 = fresh_lane(); final_norm_rows(args.in[0], (const bf16*)(ws + WS_D2), dout, args.in[25], lds, gw, NGW, wave * 64 + l17, l17); }
#undef IN
#undef SEAM
}

extern "C" void kernel_launch(void* const* d_in, const int* in_sizes, int n_in, void* d_out, int out_size, void* d_ws, size_t ws_size, hipStream_t stream) {
    static int grid = 0;
    if (grid == 0) {
        if (n_in != 26 || in_sizes[0] != M * D || out_size != M * D || ws_size < WS_END) { fprintf(stderr, "kernel_launch: unexpected shapes / workspace (n_in %d, ws %zu); nothing launched\n", n_in, ws_size); grid = -1; return; }
        int dev = 0, cus = 0, per_cu = 0;
        if (hipGetDevice(&dev) != hipSuccess || hipDeviceGetAttribute(&cus, hipDeviceAttributeMultiprocessorCount, dev) != hipSuccess) { grid = -1; return; }
        if (hipFuncSetAttribute((const void*)mk_fwd, hipFuncAttributeMaxDynamicSharedMemorySize, LDS_BYTES) != hipSuccess) { fprintf(stderr, "kernel_launch: hipFuncSetAttribute failed\n"); grid = -1; return; }
        if (hipOccupancyMaxActiveBlocksPerMultiprocessor(&per_cu, (const void*)mk_fwd, NWAVES * 64, LDS_BYTES) != hipSuccess || per_cu < 1)
            fprintf(stderr, "kernel_launch: note: occupancy query reports %d workgroups per CU\n", per_cu);
        (void)hipGetLastError();
        grid = cus;
    }
    if (grid < 0) return;
    if (hipMemsetAsync((char*)d_ws + WS_CTL, 0, CTL_ZERO_BYTES, stream) != hipSuccess) return;
    Args a{};
    for (int i = 0; i < 26; ++i) a.in[i] = (const float*)d_in[i];
    a.out = (float*)d_out; a.ws = (unsigned char*)d_ws;
    constexpr int NPH = 18;
    if (MK_N_LAUNCHES == 1) { a.ph_lo = 0; a.ph_hi = NPH; a.li = 0; hipLaunchKernelGGL(mk_fwd, dim3(grid), dim3(NWAVES * 64), LDS_BYTES, stream, a); }
    else { static const int reps[NPH] = {PROBE_REPS};
        for (int p = 0; p < NPH; ++p) for (int r = 0; r < reps[p]; ++r) { a.ph_lo = p; a.ph_hi = p + 1; a.li = 0; hipLaunchKernelGGL(mk_fwd, dim3(grid), dim3(NWAVES * 64), LDS_BYTES, stream, a); } }
    const hipError_t le = hipPeekAtLastError();
    if (le != hipSuccess) fprintf(stderr, "kernel_launch: launch failed: %s\n", hipGetErrorName(le));
}
```

```cpp
#include <hip/hip_runtime.h>
#include <cstdio>
#include <cstdint>
namespace pg8 {
#define PG8_LAS __attribute__((address_space(3)))
typedef unsigned short bf16_t;
typedef short bf16x8 __attribute__((ext_vector_type(8)));
typedef float f32x4 __attribute__((ext_vector_type(4)));
typedef unsigned u32x4 __attribute__((ext_vector_type(4)));
constexpr int BM = 256, BK = 64, HALF = 128, HTB = HALF * BK * 2  , STAGE_BYTES = 8 * HTB, NXCD = 8, WGM = 8;

__host__ __device__ __forceinline__ int lds_byte(int r, int c) { const int st = (r >> 4) * 2 + (c >> 5), rr = r & 15, cc = c & 31, ob = rr * 64 + cc * 2; return st * 1024 + (ob ^ (((ob >> 9) & 1) << 5)); }
__host__ __device__ __forceinline__ void stage_rc(int b, int& R, int& C) { const int st = b / 1024, sb = b % 1024, swz = sb ^ (((sb >> 9) & 1) << 5); R = (st >> 1) * 16 + swz / 64; C = (st & 1) * 32 + (swz % 64) / 2; }
__host__ __device__ __forceinline__ int perm32(int rho) { const int n = rho >> 4, i = rho & 15; return 8 * (i >> 2) + 4 * n + (i & 3); }

struct Unit { int pm, pn; };
struct Gemm { const bf16_t* A; const bf16_t* Bt; int M, N, K; int seg_tiles; size_t a_seg_bytes; };

struct StaticOrder {
    int nM, nN, nwg, G, c;
    __host__ __device__ void init(int M, int N, int G_, int c_) { nM = M / BM; nN = N / BM; nwg = nM * nN; G = G_; c = c_; }
    __host__ __device__ bool next(int i, Unit& u) const {
        const long L = (long)i * G + c; if (L >= nwg) return false;
        int wgid = (int)L; { const int q = nwg / NXCD, r = nwg % NXCD, xcd = wgid % NXCD, off = wgid / NXCD; wgid = (xcd < r ? xcd * (q + 1) : r * (q + 1) + (xcd - r) * q) + off; }
        const int nig = WGM * nN, gid = wgid / nig, fm = gid * WGM, gsz = (nM - fm) < WGM ? (nM - fm) : WGM;
        u.pm = fm + ((wgid % nig) % gsz); u.pn = (wgid % nig) / gsz; return true;
    }
    __device__ __forceinline__ void a_ready(const Unit&) const {}
    __device__ __forceinline__ void done(const Unit&) const {}
};

__device__ __forceinline__ unsigned cvt_pk_bf16(float lo, float hi) { unsigned r; asm volatile("v_cvt_pk_bf16_f32 %0, %1, %2" : "=v"(r) : "v"(lo), "v"(hi)); return r; }
__device__ __forceinline__ float bf_lo(unsigned w) { return __builtin_bit_cast(float, w << 16); }
__device__ __forceinline__ float bf_hi(unsigned w) { return __builtin_bit_cast(float, w & 0xffff0000u); }
__device__ __forceinline__ float sigmoidf_(float x) { return __builtin_amdgcn_rcpf(1.0f + __expf(-x)); }
__device__ __forceinline__ u32x4 pack8(const f32x4 v0, const f32x4 v1) { u32x4 w; w.x = cvt_pk_bf16(v0[0], v0[1]); w.y = cvt_pk_bf16(v0[2], v0[3]); w.z = cvt_pk_bf16(v1[0], v1[1]); w.w = cvt_pk_bf16(v1[2], v1[3]); return w; }
__device__ __forceinline__ void unpack8(const u32x4 w, f32x4& v0, f32x4& v1) { v0 = (f32x4){bf_lo(w.x), bf_hi(w.x), bf_lo(w.y), bf_hi(w.y)}; v1 = (f32x4){bf_lo(w.z), bf_hi(w.z), bf_lo(w.w), bf_hi(w.w)}; }

#define EPI_LOOP_BEGIN \
    _Pragma("unroll") for (int ai = 0; ai < 2; ++ai) _Pragma("unroll") for (int m = 0; m < 4; ++m) { const int row = row0 + ai * HALF + m * 16; \
    _Pragma("unroll") for (int bj = 0; bj < 2; ++bj) { const int col = col0 + bj * HALF; const f32x4 a0 = acc[ai][bj][m][0], a1 = acc[ai][bj][m][1];
#define EPI_LOOP_END } }

struct EpiProj {
    static constexpr bool PERM = true, AFTER_DRAIN = false, HAS_MID = false;
    bf16_t *PS, *PC, *PG;
    __device__ __forceinline__ void operator()(const f32x4 (&acc)[2][2][4][2], const Unit& u, int wr, int wc, int fr, int fq) const {
        bf16_t* base; int ld, colt;
        if (u.pn < 26) { base = PS; ld = 6656; colt = u.pn * BM; } else if (u.pn < 50) { base = PC; ld = 6144; colt = (u.pn - 26) * BM; } else { base = PG; ld = 8192; colt = (u.pn - 50) * BM; }
        const int row0 = u.pm * BM + wr * 64 + fr, col0 = colt + wc * 32 + 8 * fq;
        EPI_LOOP_BEGIN
            *(u32x4*)(base + (size_t)row * ld + col) = pack8(a0, a1);
        EPI_LOOP_END
    }
};
struct EpiPlain {
    static constexpr bool PERM = true, AFTER_DRAIN = false, HAS_MID = false;
    bf16_t* O; int ld;
    __device__ __forceinline__ void operator()(const f32x4 (&acc)[2][2][4][2], const Unit& u, int wr, int wc, int fr, int fq) const {
        const int row0 = u.pm * BM + wr * 64 + fr, col0 = u.pn * BM + wc * 32 + 8 * fq;
        EPI_LOOP_BEGIN
            *(u32x4*)(O + (size_t)row * ld + col) = pack8(a0, a1);
        EPI_LOOP_END
    }
};
struct EpiLora {
    static constexpr bool PERM = true, AFTER_DRAIN = false, HAS_MID = false;
    float* WD; bf16_t* ICLR; bf16_t* G; const float* w0p; const float* a0p;
    __device__ __forceinline__ void operator()(const f32x4 (&acc)[2][2][4][2], const Unit& u, int wr, int wc, int fr, int fq) const {
        const int seg = u.pn >> 3;
        const int row0 = u.pm * BM + wr * 64 + fr, col0 = (u.pn & 7) * BM + wc * 32 + 8 * fq;
        if (seg == 0) {
            EPI_LOOP_BEGIN
                const f32x4 b0 = *(const f32x4*)(w0p + col), b1 = *(const f32x4*)(w0p + col + 4);
                *(f32x4*)(WD + (size_t)row * 2048 + col) = b0 + a0; *(f32x4*)(WD + (size_t)row * 2048 + col + 4) = b1 + a1;
            EPI_LOOP_END
        } else if (seg == 1) {
            EPI_LOOP_BEGIN
                const f32x4 b0 = *(const f32x4*)(a0p + col), b1 = *(const f32x4*)(a0p + col + 4);
                f32x4 o0, o1;
#pragma unroll
                for (int e2 = 0; e2 < 4; ++e2) { o0[e2] = sigmoidf_(b0[e2] + a0[e2]); o1[e2] = sigmoidf_(b1[e2] + a1[e2]); }
                *(u32x4*)(ICLR + (size_t)row * 2048 + col) = pack8(o0, o1);
            EPI_LOOP_END
        } else {
            EPI_LOOP_BEGIN
                *(u32x4*)(G + (size_t)row * 2048 + col) = pack8(a0, a1);
            EPI_LOOP_END
        }
    }
};
struct EpiMix {
    static constexpr bool PERM = true, AFTER_DRAIN = false, HAS_MID = true;
    const bf16_t* PG; bf16_t* MG;
    __device__ __forceinline__ void mid(f32x4 (&acc)[2][2][4][2], const Unit& u, int wr, int wc, int fr, int fq) const {
        asm volatile("" : "+v"(fr), "+v"(fq));
        const int row0 = u.pm * BM + wr * 64 + fr, col0 = u.pn * BM + wc * 32 + 8 * fq;
#pragma unroll
        for (int ai = 0; ai < 2; ++ai)
#pragma unroll
            for (int mp = 0; mp < 2; ++mp) {
                u32x4 ga[4], gb[4];
#pragma unroll
                for (int mm = 0; mm < 2; ++mm)
#pragma unroll
                    for (int bj = 0; bj < 2; ++bj) { const bf16_t* p = PG + (size_t)(row0 + ai * HALF + (mp * 2 + mm) * 16) * 8192 + col0 + bj * HALF; ga[mm * 2 + bj] = *(const u32x4*)p; gb[mm * 2 + bj] = *(const u32x4*)(p + 4096); }
                asm volatile("" : "+v"(ga[0]), "+v"(ga[1]), "+v"(ga[2]), "+v"(ga[3]), "+v"(gb[0]), "+v"(gb[1]), "+v"(gb[2]), "+v"(gb[3]));
#pragma unroll
                for (int mm = 0; mm < 2; ++mm)
#pragma unroll
                    for (int bj = 0; bj < 2; ++bj) { const int m = mp * 2 + mm; f32x4 a0, a1, b0, b1; unpack8(ga[mm * 2 + bj], a0, a1); unpack8(gb[mm * 2 + bj], b0, b1);
#pragma unroll
                        for (int e2 = 0; e2 < 4; ++e2) {
                            acc[ai][bj][m][0][e2] *= (1.0f + __expf(-b0[e2])) * __builtin_amdgcn_rcpf(1.0f + __expf(-a0[e2]));
                            acc[ai][bj][m][1][e2] *= (1.0f + __expf(-b1[e2])) * __builtin_amdgcn_rcpf(1.0f + __expf(-a1[e2])); } }
            }
    }
    __device__ __forceinline__ void operator()(const f32x4 (&acc)[2][2][4][2], const Unit& u, int wr, int wc, int fr, int fq) const {
        const int row0 = u.pm * BM + wr * 64 + fr, col0 = u.pn * BM + wc * 32 + 8 * fq;
#pragma unroll
        for (int ai = 0; ai < 2; ++ai) {
            u32x4 gw[8];
#pragma unroll
            for (int m = 0; m < 4; ++m)
#pragma unroll
                for (int bj = 0; bj < 2; ++bj) gw[m * 2 + bj] = *(const u32x4*)(PG + (size_t)(row0 + ai * HALF + m * 16) * 8192 + 4096 + col0 + bj * HALF);
            asm volatile("" : "+v"(gw[0]), "+v"(gw[1]), "+v"(gw[2]), "+v"(gw[3]), "+v"(gw[4]), "+v"(gw[5]), "+v"(gw[6]), "+v"(gw[7]));
#pragma unroll
            for (int m = 0; m < 4; ++m)
#pragma unroll
                for (int bj = 0; bj < 2; ++bj) { const int row = row0 + ai * HALF + m * 16, col = col0 + bj * HALF; const f32x4 a0 = acc[ai][bj][m][0], a1 = acc[ai][bj][m][1];
                    f32x4 g0, g1; unpack8(gw[m * 2 + bj], g0, g1); f32x4 o0, o1;
#pragma unroll
                    for (int e2 = 0; e2 < 4; ++e2) { o0[e2] = sigmoidf_(g0[e2]) * a0[e2]; o1[e2] = sigmoidf_(g1[e2]) * a1[e2]; }
                    *(u32x4*)(MG + (size_t)row * 4096 + col) = pack8(o0, o1); }
        }
    }
};
struct EpiResid {
    static constexpr bool PERM = true, AFTER_DRAIN = false, HAS_MID = false;
    const float* X; float* OUT; const float* gate;
    __device__ __forceinline__ void operator()(const f32x4 (&acc)[2][2][4][2], const Unit& u, int wr, int wc, int fr, int fq) const {
        const int row0 = u.pm * BM + wr * 64 + fr, col0 = u.pn * BM + wc * 32 + 8 * fq;
        const float* gp = gate + (size_t)(u.pm >> 5) * 24576;
        f32x4 gt[2][2];
#pragma unroll
        for (int bj = 0; bj < 2; ++bj) { gt[bj][0] = *(const f32x4*)(gp + col0 + bj * HALF); gt[bj][1] = *(const f32x4*)(gp + col0 + bj * HALF + 4); }
#pragma unroll
        for (int ai = 0; ai < 2; ++ai) {
            f32x4 xv[16];
#pragma unroll
            for (int m = 0; m < 4; ++m)
#pragma unroll
                for (int bj = 0; bj < 2; ++bj) { const float* xp = X + (size_t)(row0 + ai * HALF + m * 16) * 4096 + col0 + bj * HALF; xv[(m * 2 + bj) * 2] = *(const f32x4*)xp; xv[(m * 2 + bj) * 2 + 1] = *(const f32x4*)(xp + 4); }
            asm volatile("" : "+v"(xv[0]), "+v"(xv[1]), "+v"(xv[2]), "+v"(xv[3]), "+v"(xv[4]), "+v"(xv[5]), "+v"(xv[6]), "+v"(xv[7]), "+v"(xv[8]), "+v"(xv[9]), "+v"(xv[10]), "+v"(xv[11]), "+v"(xv[12]), "+v"(xv[13]), "+v"(xv[14]), "+v"(xv[15]));
#pragma unroll
            for (int m = 0; m < 4; ++m)
#pragma unroll
                for (int bj = 0; bj < 2; ++bj) { float* op = OUT + (size_t)(row0 + ai * HALF + m * 16) * 4096 + col0 + bj * HALF;
                    *(f32x4*)op = xv[(m * 2 + bj) * 2] + gt[bj][0] * acc[ai][bj][m][0]; *(f32x4*)(op + 4) = xv[(m * 2 + bj) * 2 + 1] + gt[bj][1] * acc[ai][bj][m][1]; }
        }
    }
};
struct EpiAct {
    static constexpr bool PERM = true, AFTER_DRAIN = false, HAS_MID = false;
    bf16_t* ACT; const float* cw; bf16_t* HG0; bf16_t* HV0; bf16_t* HG1;
    __device__ __forceinline__ void operator()(const f32x4 (&acc)[2][2][4][2], const Unit& u, int wr, int wc, int fr, int fq) const {
        constexpr int FFc = 11008;
        const int ch0 = u.pn * 128 + wc * 32 + 8 * fq;
        float w0[8], w1[8], w2[8];
#pragma unroll
        for (int h = 0; h < 2; ++h) { const f32x4 a = *(const f32x4*)(cw + ch0 + 4 * h), b = *(const f32x4*)(cw + FFc + ch0 + 4 * h), c = *(const f32x4*)(cw + 2 * FFc + ch0 + 4 * h);
#pragma unroll
            for (int ee = 0; ee < 4; ++ee) { w0[4 * h + ee] = a[ee]; w1[4 * h + ee] = b[ee]; w2[4 * h + ee] = c[ee]; } }
#pragma unroll
        for (int ai = 0; ai < 2; ++ai) {
            const int blk = u.pm * 4 + ai * 2 + wr;
            const int rowb = u.pm * BM + ai * HALF + wr * 64 + fr;
#pragma unroll
            for (int m = 0; m < 4; ++m) {
                float o[8];
#pragma unroll
                for (int n = 0; n < 2; ++n)
#pragma unroll
                    for (int ee = 0; ee < 4; ++ee) {
                        const int c = 4 * n + ee; const float x = acc[ai][0][m][n][ee]; float y;
                        asm volatile("s_nop 1\n\t"
                                     "v_mul_f32 %0, %1, %4\n\t"
                                     "v_fmac_f32_dpp %0, %1, %3 row_shr:1 row_mask:0xf bank_mask:0xf\n\t"
                                     "v_fmac_f32_dpp %0, %1, %2 row_shr:2 row_mask:0xf bank_mask:0xf"
                                     : "=&v"(y) : "v"(x), "v"(w0[c]), "v"(w1[c]), "v"(w2[c]));
                        if (m > 0) { const float xp = acc[ai][0][m - 1][n][ee];
                            asm volatile("s_nop 1\n\t"
                                         "v_fmac_f32_dpp %0, %1, %3 row_shl:15 row_mask:0xf bank_mask:0xf\n\t"
                                         "v_fmac_f32_dpp %0, %1, %2 row_shl:14 row_mask:0xf bank_mask:0xf"
                                         : "+v"(y) : "v"(xp), "v"(w0[c]), "v"(w1[c])); }
                        o[c] = y * sigmoidf_(y) * acc[ai][1][m][n][ee];
                    }
                const u32x4 ov = pack8((f32x4){o[0], o[1], o[2], o[3]}, (f32x4){o[4], o[5], o[6], o[7]});
                if (m > 0 || fr >= 2) *(u32x4*)(ACT + (size_t)(rowb + m * 16) * FFc + ch0) = ov;
                if (m == 0 && fr < 2) { *(u32x4*)(HG0 + ((size_t)blk * 2 + fr) * FFc + ch0) = pack8(acc[ai][0][0][0], acc[ai][0][0][1]); *(u32x4*)(HV0 + ((size_t)blk * 2 + fr) * FFc + ch0) = pack8(acc[ai][1][0][0], acc[ai][1][0][1]); }
                if (m == 3 && fr >= 14) *(u32x4*)(HG1 + ((size_t)blk * 2 + (fr - 14)) * FFc + ch0) = pack8(acc[ai][0][3][0], acc[ai][0][3][1]);
            }
        }
    }
};
struct EpiDelta {
    static constexpr bool PERM = true, AFTER_DRAIN = false, HAS_MID = false;
    bf16_t* OUT; const float* gate;
    __device__ __forceinline__ void operator()(const f32x4 (&acc)[2][2][4][2], const Unit& u, int wr, int wc, int fr, int fq) const {
        const int row0 = u.pm * BM + wr * 64 + fr, col0 = u.pn * BM + wc * 32 + 8 * fq;
        const float* gp = gate + (size_t)(u.pm >> 5) * 24576;
        f32x4 gt[2][2];
#pragma unroll
        for (int bj = 0; bj < 2; ++bj) { gt[bj][0] = *(const f32x4*)(gp + col0 + bj * HALF); gt[bj][1] = *(const f32x4*)(gp + col0 + bj * HALF + 4); }
        EPI_LOOP_BEGIN
            *(u32x4*)(OUT + (size_t)row * 4096 + col) = pack8(gt[bj][0] * a0, gt[bj][1] * a1);
        EPI_LOOP_END
    }
};
struct EpiDeltaSum {
    static constexpr bool PERM = true, AFTER_DRAIN = false, HAS_MID = false;
    bf16_t* OUT; const float* gate; const bf16_t* ADD;
    __device__ __forceinline__ void operator()(const f32x4 (&acc)[2][2][4][2], const Unit& u, int wr, int wc, int fr, int fq) const {
        const int row0 = u.pm * BM + wr * 64 + fr, col0 = u.pn * BM + wc * 32 + 8 * fq;
        const float* gp = gate + (size_t)(u.pm >> 5) * 24576;
        f32x4 gt[2][2];
#pragma unroll
        for (int bj = 0; bj < 2; ++bj) { gt[bj][0] = *(const f32x4*)(gp + col0 + bj * HALF); gt[bj][1] = *(const f32x4*)(gp + col0 + bj * HALF + 4); }
        EPI_LOOP_BEGIN
            f32x4 d0, d1; unpack8(*(const u32x4*)(ADD + (size_t)row * 4096 + col), d0, d1);
            *(u32x4*)(OUT + (size_t)row * 4096 + col) = pack8(gt[bj][0] * a0 + d0, gt[bj][1] * a1 + d1);
        EPI_LOOP_END
    }
};
#undef EPI_LOOP_BEGIN
#undef EPI_LOOP_END

template <class Epi, class Sched, bool ALIGN_EPI = false, bool SP2 = false, int HALFK_PN = 0>
__device__ __forceinline__ void gemm_phase(PG8_LAS unsigned char* lds, const Gemm g, const Sched& S, const Epi& E) {
    int tid_ = threadIdx.x; asm volatile("" : "+v"(tid_));
    const int tid = tid_, wid = __builtin_amdgcn_readfirstlane(tid >> 6), lane = tid & 63, wr = wid >> 2, wc = wid & 3, fr = lane & 15, fq = lane >> 4;
    const int K = g.K, ntf = K / BK;
    unsigned voffA[2], voffB[2];
#pragma unroll
    for (int i = 0; i < 2; ++i) { int R, C; stage_rc(tid * 16 + i * 8192, R, C); const int Rb = Epi::PERM ? ((R & ~31) + perm32(R & 31)) : R;
        voffA[i] = (unsigned)(R * K + C) * 2u; voffB[i] = (unsigned)(Rb * K + C) * 2u; }
    const size_t kstep = (size_t)(BK * 2);
    const size_t hstep = (size_t)HALF * K * 2;
    const size_t tstep = 2 * hstep;
    const unsigned ldsw = (unsigned)wid * 1024u;
    const int aoff = lds_byte(wr * 64 + fr, fq * 8), boff = lds_byte(wc * 32 + fr, fq * 8);
#define PG8_SA(b, h) (((b) * 2 + (h)) * HTB)
#define PG8_SB(b, h) ((4 + (b) * 2 + (h)) * HTB)
#define PG8_STAGE(bufoff, gbase, voff) do { _Pragma("unroll") for (int _i = 0; _i < 2; ++_i) \
        __builtin_amdgcn_global_load_lds((const unsigned*)((const char*)(gbase) + (voff)[_i]), (PG8_LAS unsigned*)(lds + (bufoff) + ldsw + _i * 8192), 16, 0, 0); } while (0)
#define PG8_LDA(dst, b, h) do { _Pragma("unroll") for (int m = 0; m < 4; ++m) _Pragma("unroll") for (int k = 0; k < 2; ++k) dst[m][k] = *(const PG8_LAS bf16x8*)(lds + PG8_SA(b, h) + aoff + m * 2048 + k * 1024); } while (0)
#define PG8_LDB(dst, b, h) do { _Pragma("unroll") for (int n = 0; n < 2; ++n) _Pragma("unroll") for (int k = 0; k < 2; ++k) dst[n][k] = *(const PG8_LAS bf16x8*)(lds + PG8_SB(b, h) + boff + n * 2048 + k * 1024); } while (0)
#define PG8_MMA(ai, bj, At, Bt) do { __builtin_amdgcn_s_setprio(1); _Pragma("unroll") for (int m = 0; m < 4; ++m) _Pragma("unroll") for (int n = 0; n < 2; ++n) _Pragma("unroll") for (int k = 0; k < 2; ++k) \
        acc[ai][bj][m][n] = __builtin_amdgcn_mfma_f32_16x16x32_bf16(Bt[n][k], At[m][k], acc[ai][bj][m][n], 0, 0, 0); __builtin_amdgcn_s_setprio(0); } while (0)
#define PG8_WAIT_V(n) asm volatile("s_waitcnt vmcnt(" #n ")" ::: "memory")
#define PG8_WAIT_L(n) asm volatile("s_waitcnt lgkmcnt(" #n ")" ::: "memory")
#define PG8_BAR __builtin_amdgcn_s_barrier()
#define PG8_SCHED __builtin_amdgcn_sched_barrier(0)
    Unit cur, nxt; int ui = 0;
    if (!S.next(0, cur)) return;
    f32x4 acc[2][2][4][2];
#pragma unroll
    for (int a = 0; a < 2; ++a)
#pragma unroll
        for (int b = 0; b < 2; ++b)
#pragma unroll
            for (int m = 0; m < 4; ++m)
#pragma unroll
                for (int n = 0; n < 2; ++n) acc[a][b][m][n] = (f32x4){0.f, 0.f, 0.f, 0.f};
    bf16x8 At[4][2], B0[2][2], B1[2][2];
    const char* cA = (const char*)g.A + (size_t)cur.pm * tstep + (size_t)(cur.pn / g.seg_tiles) * g.a_seg_bytes; const char* cB = (const char*)g.Bt + (size_t)cur.pn * tstep;
    S.a_ready(cur);
    if constexpr (SP2) {
        PG8_STAGE(PG8_SB(0, 0), cB, voffB); PG8_STAGE(PG8_SB(0, 1), cB + hstep, voffB); PG8_STAGE(PG8_SA(0, 0), cA, voffA); PG8_STAGE(PG8_SA(0, 1), cA + hstep, voffA);
        if (wr == 1) PG8_BAR;
        PG8_WAIT_V(2); PG8_BAR;
        PG8_STAGE(PG8_SB(1, 0), cB + kstep, voffB); PG8_STAGE(PG8_SA(1, 0), cA + kstep, voffA); PG8_STAGE(PG8_SB(1, 1), cB + hstep + kstep, voffB);
        PG8_WAIT_V(6); PG8_BAR;
    } else {
        PG8_STAGE(PG8_SB(0, 0), cB, voffB); PG8_STAGE(PG8_SA(0, 0), cA, voffA); PG8_STAGE(PG8_SB(0, 1), cB + hstep, voffB); PG8_STAGE(PG8_SA(0, 1), cA + hstep, voffA);
        if (wr == 1) PG8_BAR;
        PG8_WAIT_V(4); PG8_BAR;
        PG8_STAGE(PG8_SB(1, 0), cB + kstep, voffB); PG8_STAGE(PG8_SA(1, 0), cA + kstep, voffA); PG8_STAGE(PG8_SB(1, 1), cB + hstep + kstep, voffB);
        PG8_WAIT_V(6); PG8_BAR;
    }
    for (;;) {
        const bool has_next = S.next(ui + 1, nxt);
        const char* nA = has_next ? (const char*)g.A + (size_t)nxt.pm * tstep + (size_t)(nxt.pn / g.seg_tiles) * g.a_seg_bytes : cA; const char* nB = has_next ? (const char*)g.Bt + (size_t)nxt.pn * tstep : cB;
        int nt = ntf;
        if constexpr (HALFK_PN > 0) { if (cur.pn < HALFK_PN) nt = ntf / 2; }
        for (int t = 0; t < nt; t += 2) {
            const bool last = (t == nt - 2);
            const char* a1 = cA + (size_t)(t + 1) * kstep;
            const char* a2 = last ? nA : cA + (size_t)(t + 2) * kstep; const char* b2 = last ? nB : cB + (size_t)(t + 2) * kstep;
            const char* a3 = a2 + kstep; const char* b3 = b2 + kstep;
            if (last && has_next) S.a_ready(nxt);
            if constexpr (Epi::HAS_MID) { if (t == ntf / 2) E.mid(acc, cur, wr, wc, fr, fq); }
            if constexpr (SP2) {
            PG8_LDB(B0, 0, 0); PG8_LDB(B1, 0, 1); PG8_SCHED; PG8_LDA(At, 0, 0); PG8_STAGE(PG8_SA(1, 1), a1 + hstep, voffA);
            PG8_WAIT_V(8); PG8_WAIT_L(0); PG8_BAR; PG8_MMA(0, 0, At, B0); PG8_MMA(0, 1, At, B1); PG8_BAR; PG8_SCHED;
            PG8_LDA(At, 0, 1); PG8_STAGE(PG8_SB(0, 0), b2, voffB); PG8_STAGE(PG8_SB(0, 1), b2 + hstep, voffB); PG8_STAGE(PG8_SA(0, 0), a2, voffA);
            PG8_WAIT_V(8); PG8_WAIT_L(0); PG8_BAR; PG8_MMA(1, 0, At, B0); PG8_MMA(1, 1, At, B1); PG8_BAR; PG8_SCHED;
            PG8_LDB(B0, 1, 0); PG8_LDB(B1, 1, 1); PG8_SCHED; PG8_LDA(At, 1, 0); PG8_STAGE(PG8_SA(0, 1), a2 + hstep, voffA);
            PG8_WAIT_V(8); PG8_WAIT_L(0); PG8_BAR; PG8_MMA(0, 0, At, B0); PG8_MMA(0, 1, At, B1); PG8_BAR; PG8_SCHED;
            PG8_LDA(At, 1, 1); PG8_STAGE(PG8_SB(1, 0), b3, voffB); PG8_STAGE(PG8_SB(1, 1), b3 + hstep, voffB); PG8_STAGE(PG8_SA(1, 0), a3, voffA);
            PG8_WAIT_V(8); PG8_WAIT_L(0); PG8_BAR; PG8_MMA(1, 0, At, B0); PG8_MMA(1, 1, At, B1); PG8_BAR; PG8_SCHED;
            } else {
            PG8_LDB(B0, 0, 0); PG8_SCHED; PG8_LDA(At, 0, 0); PG8_STAGE(PG8_SA(1, 1), a1 + hstep, voffA);
            PG8_WAIT_L(8); PG8_BAR; PG8_WAIT_L(0); PG8_MMA(0, 0, At, B0); PG8_BAR; PG8_SCHED;
            PG8_LDB(B1, 0, 1); PG8_STAGE(PG8_SB(0, 0), b2, voffB);
            PG8_BAR; PG8_WAIT_L(0); PG8_MMA(0, 1, At, B1); PG8_BAR;
            PG8_LDA(At, 0, 1); PG8_STAGE(PG8_SA(0, 0), a2, voffA);
            PG8_BAR; PG8_WAIT_L(0); PG8_MMA(1, 0, At, B0); PG8_BAR; PG8_SCHED;
            PG8_STAGE(PG8_SB(0, 1), b2 + hstep, voffB);
            PG8_WAIT_V(6); PG8_BAR; PG8_MMA(1, 1, At, B1); PG8_BAR;
            PG8_LDB(B0, 1, 0); PG8_SCHED; PG8_LDA(At, 1, 0); PG8_STAGE(PG8_SA(0, 1), a2 + hstep, voffA);
            PG8_WAIT_L(8); PG8_BAR; PG8_WAIT_L(0); PG8_MMA(0, 0, At, B0); PG8_BAR; PG8_SCHED;
            PG8_LDB(B1, 1, 1); PG8_STAGE(PG8_SB(1, 0), b3, voffB);
            PG8_BAR; PG8_WAIT_L(0); PG8_MMA(0, 1, At, B1); PG8_BAR;
            PG8_LDA(At, 1, 1); PG8_STAGE(PG8_SA(1, 0), a3, voffA);
            PG8_BAR; PG8_WAIT_L(0); PG8_MMA(1, 0, At, B0); PG8_BAR; PG8_SCHED;
            PG8_STAGE(PG8_SB(1, 1), b3 + hstep, voffB);
            PG8_WAIT_V(6); PG8_BAR; PG8_MMA(1, 1, At, B1); PG8_BAR;
            }
        }
        if constexpr (ALIGN_EPI) { if (wr == 0) PG8_BAR; }
        if constexpr (!Epi::AFTER_DRAIN) { E(acc, cur, wr, wc, fr, fq); S.done(cur); }
        if (!has_next) break;
#pragma unroll
        for (int a = 0; a < 2; ++a)
#pragma unroll
            for (int b = 0; b < 2; ++b)
#pragma unroll
                for (int m = 0; m < 4; ++m)
#pragma unroll
                    for (int n = 0; n < 2; ++n) acc[a][b][m][n] = (f32x4){0.f, 0.f, 0.f, 0.f};
        cur = nxt; cA = nA; cB = nB; ++ui;
        if constexpr (ALIGN_EPI) { if (wr == 1) PG8_BAR; }
    }
    PG8_WAIT_V(0);
    if constexpr (!ALIGN_EPI) { if (wr == 0) PG8_BAR; }
    PG8_BAR;
    if constexpr (Epi::AFTER_DRAIN) { E.fused(acc, cur, wr, wc, fr, fq, lds, wid, lane); S.done(cur); }
#undef PG8_SA
#undef PG8_SB
#undef PG8_STAGE
#undef PG8_LDA
#undef PG8_LDB
#undef PG8_MMA
#undef PG8_WAIT_V
#undef PG8_WAIT_L
#undef PG8_BAR
#undef PG8_SCHED
}
}

#ifndef PG8_SP2
#define PG8_SP2 true
#endif
#ifndef PG8_ALIGN
#define PG8_ALIGN true
#endif
#ifndef PROBE_REPS
#define PROBE_REPS 1,1,1,1,1,1,1,1,1,1,1,1,1,1,1,1,1,1
#endif
#ifndef MK_N_LAUNCHES
#define MK_N_LAUNCHES 1
#endif

constexpr int NWAVES = 8;
constexpr int BATCH = 2, T = 8192, D = 4096, DR = 2048, NH = 32, HD = 64, FF = 11008;
constexpr int M = BATCH * T;
constexpr int N_SHIFT = 6592, N_IN = 20928;
constexpr int N_INP = 20992;
constexpr int LD_PS = 6656, LD_PC = 6144, LD_PG = 8192, NUP = 2 * FF;
constexpr int NADA = 6 * D;
constexpr int NSEG = 32, SEGLEN = T / NSEG;
constexpr float NORM_EPS = 1e-6f, LNX_EPS = 64e-5f;

constexpr size_t MiB = 1u << 20;
constexpr size_t WS_CTL = 0, CTL_ZERO_BYTES = 1 * MiB;
constexpr size_t WS_PART = 1 * MiB;
constexpr size_t WS_MOD = 7 * MiB;
constexpr size_t WS_WLORA = 8 * MiB;
constexpr size_t WS_WOCAT = 12 * MiB, WS_WOUT = 44 * MiB;
constexpr size_t WS_WIN = 76 * MiB;
constexpr size_t WS_H = 240 * MiB;
constexpr size_t WS_PS = 368 * MiB;
constexpr size_t WS_PC = 576 * MiB;
constexpr size_t WS_PG = 768 * MiB;
constexpr size_t WS_ALORA = 76 * MiB;
constexpr size_t WS_OCB = 240 * MiB;
constexpr size_t WS_G = 164 * MiB;
constexpr size_t WS_BONUS = 228 * MiB;
constexpr size_t WS_CEND = 230 * MiB;
constexpr size_t WS_WD = 1024 * MiB, WS_ICLR = 1152 * MiB, WS_R = 1280 * MiB, WS_KK = 1408 * MiB;
constexpr size_t WS_BV = 576 * MiB;
constexpr size_t WS_PBUF = 704 * MiB, WS_QBUF = 736 * MiB;
constexpr size_t WS_PT = 1152 * MiB;
constexpr size_t WS_YQ = 368 * MiB;
constexpr size_t WS_SST = 100 * MiB;
constexpr size_t WS_PQ = 1024 * MiB;
constexpr size_t WS_MERGED = 1280 * MiB;
constexpr size_t WS_H2 = 12 * MiB;
constexpr size_t WS_WUP = 140 * MiB;
constexpr size_t WS_WDOWN = 312 * MiB;
constexpr size_t WS_HG0 = 398 * MiB, WS_HV0 = 410 * MiB, WS_HG1 = 422 * MiB;
constexpr size_t WS_ACT = 1086 * MiB;
constexpr size_t WS_D1 = 440 * MiB, WS_D2 = 568 * MiB;
constexpr size_t WS_END = 1536 * MiB;
constexpr int CW_TMO = 0, CW_CODE = 1, CW_BAR = 4096, CW_MODCNT = 150000;

constexpr int RING_OFF = 0, RING_BYTES = 131072;
constexpr int LDSCTL_OFF = RING_BYTES, MISC_OFF = LDSCTL_OFF + 320;
constexpr int LDS_BYTES = 147456;

#define GAS __attribute__((address_space(1)))
#define LAS __attribute__((address_space(3)))
typedef unsigned short bf16;
typedef unsigned v4u __attribute__((ext_vector_type(4)));
typedef unsigned v2u __attribute__((ext_vector_type(2)));
typedef float f32x4 __attribute__((ext_vector_type(4)));
typedef float f32x2 __attribute__((ext_vector_type(2)));
typedef GAS unsigned gu32;
#define RLX_AGENT __ATOMIC_RELAXED, __HIP_MEMORY_SCOPE_AGENT
#define LDS_WAIT() asm volatile("s_waitcnt lgkmcnt(0)" ::: "memory")
#define VM_WAIT() asm volatile("s_waitcnt vmcnt(0)" ::: "memory")
__device__ __forceinline__ unsigned f2bf(float f) { unsigned u = __builtin_bit_cast(unsigned, f); return (u + 0x7fffu + ((u >> 16) & 1u)) >> 16; }
__device__ __forceinline__ unsigned pk2(float lo, float hi) { return f2bf(lo) | (f2bf(hi) << 16); }
__device__ __forceinline__ float bflo(unsigned w) { return __builtin_bit_cast(float, w << 16); }
__device__ __forceinline__ float bfhi(unsigned w) { return __builtin_bit_cast(float, w & 0xffff0000u); }
__device__ __forceinline__ float bf1(bf16 h) { return __builtin_bit_cast(float, ((unsigned)h) << 16); }
__device__ __forceinline__ float sigm(float x) { return __builtin_amdgcn_rcpf(1.0f + __expf(-x)); }
__device__ __forceinline__ float wave_sum(float v) {
#pragma unroll
    for (int o = 1; o < 64; o <<= 1) v += __shfl_xor(v, o);
    return v;
}

#define DPP_ADD(v, ctrl) ((v) + __builtin_bit_cast(float, __builtin_amdgcn_update_dpp(0, __builtin_bit_cast(int, (v)), (ctrl), 0xf, 0xf, true)))
__device__ __forceinline__ float wave_sum_dpp(float v) {
    v = DPP_ADD(v, 0xB1);
    v = DPP_ADD(v, 0x4E);
    v = DPP_ADD(v, 0x141);
    v = DPP_ADD(v, 0x140);
    const int iv = __builtin_bit_cast(int, v);
    const float r0 = __builtin_bit_cast(float, __builtin_amdgcn_readlane(iv, 0)), r1 = __builtin_bit_cast(float, __builtin_amdgcn_readlane(iv, 16));
    const float r2 = __builtin_bit_cast(float, __builtin_amdgcn_readlane(iv, 32)), r3 = __builtin_bit_cast(float, __builtin_amdgcn_readlane(iv, 48));
    return (r0 + r1) + (r2 + r3);
}

#define XB_TMO      128
#define XB_XCNT(j)  (256  + 64 * (j))
#define XB_XSUB(j)  (1280 + 64 * (j))
#define XB_XGEN(j)  (2304 + 64 * (j))
#define XB_TOP      3328
#define XB_TOPGEN   3392
#define XCD_BAR_WORDS 3456
#define XB_SPIN_CAP (1u << 18)

__device__ __forceinline__ unsigned xb_ld(unsigned* p)              { return __hip_atomic_load(p, __ATOMIC_RELAXED, __HIP_MEMORY_SCOPE_AGENT); }
__device__ __forceinline__ unsigned xb_add(unsigned* p, unsigned v) { return __hip_atomic_fetch_add(p, v, __ATOMIC_RELAXED, __HIP_MEMORY_SCOPE_AGENT); }
__device__ __forceinline__ unsigned xb_xcc_id() { return (unsigned)__builtin_amdgcn_s_getreg((3 << 11) | 20) & 0xFu; }
#define XB_SPIN(cond, bar) do { unsigned _sp = 0; while (cond) { __builtin_amdgcn_s_sleep(1); \
    if ((++_sp & 255u) == 0u) { if (xb_ld(&(bar)[XB_TMO])) break; if (_sp > XB_SPIN_CAP) { atomicAdd(&(bar)[XB_TMO], 1u); break; } } } } while (0)

struct XcdBarrier {
    unsigned* bar; unsigned x;
    volatile LAS unsigned* st;
};
__device__ __forceinline__ XcdBarrier xcd_barrier_post(unsigned* bar, volatile LAS unsigned* st) {
    XcdBarrier b; b.bar = bar; b.x = xb_xcc_id(); b.st = st;
    if (threadIdx.x == 0) (void)xb_add(&bar[XB_XCNT(b.x)], 1u);
    return b;
}
__device__ __forceinline__ void xcd_barrier_complete(unsigned* bar, unsigned x, unsigned& nloc, unsigned& nx) {
    const unsigned G = gridDim.x * gridDim.y * gridDim.z;
    unsigned sum, cnt, mine, sp = 0u;
    for (;;) {
        sum = 0u; cnt = 0u; mine = 0u;
#pragma unroll
        for (unsigned j = 0; j < 16; ++j) { const unsigned c = xb_ld(&bar[XB_XCNT(j)]); sum += c; cnt += (c > 0u) ? 1u : 0u; mine = (j == x) ? c : mine; }
        if (sum == G) break;
        __builtin_amdgcn_s_sleep(1);
        if ((++sp & 255u) == 0u) { if (xb_ld(&bar[XB_TMO])) break; if (sp > XB_SPIN_CAP) { atomicAdd(&bar[XB_TMO], 1u); break; } }
    }
    nloc = mine > 0u ? mine : 1u; nx = cnt > 0u ? cnt : 1u;
}
__device__ __forceinline__ void xcd_barrier(const XcdBarrier& b) {
    asm volatile("s_waitcnt vmcnt(0)" ::: "memory");
    __syncthreads();
    if (threadIdx.x == 0) {
        unsigned* bar = b.bar;
        __builtin_amdgcn_s_waitcnt(0);
        unsigned nloc = b.st[0], nx = b.st[1];
        if (nloc == 0u) { xcd_barrier_complete(bar, b.x, nloc, nx); b.st[0] = nloc; b.st[1] = nx; }
        const unsigned old = xb_add(&bar[XB_XSUB(b.x)], 1u);
        const unsigned gen = old / nloc;
        if (old + 1u == (gen + 1u) * nloc) {
            __builtin_amdgcn_fence(__ATOMIC_RELEASE, "agent");
            asm volatile("s_waitcnt vmcnt(0)" ::: "memory");
            const unsigned og = xb_add(&bar[XB_TOP], 1u);
            const unsigned tg = og / nx;
            if (og + 1u == (tg + 1u) * nx) xb_add(&bar[XB_TOPGEN], 1u);
            else XB_SPIN(xb_ld(&bar[XB_TOPGEN]) == tg, bar);
            __builtin_amdgcn_fence(__ATOMIC_ACQUIRE, "agent");
            xb_add(&bar[XB_XGEN(b.x)], 1u);
            asm volatile("s_waitcnt vmcnt(0)" ::: "memory");
        } else {
            XB_SPIN(xb_ld(&bar[XB_XGEN(b.x)]) == gen, bar);
            __builtin_amdgcn_fence(__ATOMIC_ACQUIRE, "agent");
            asm volatile("s_waitcnt vmcnt(0)" ::: "memory");
        }
    }
    __syncthreads();
}

__device__ __forceinline__ int fresh_lane() { unsigned l; asm volatile("v_mbcnt_lo_u32_b32 %0, -1, 0\n\tv_mbcnt_hi_u32_b32 %0, -1, %0" : "=v"(l)); return (int)l; }
__device__ __forceinline__ void transpose_item(const float* W, int N, int Kd, bf16* WT, int kb, int nb, int dest_row0, LAS unsigned* scr, int lane) {
    const int k0 = kb * 64, n0 = nb * 64;
    const float* src = W + (size_t)k0 * N + n0 + lane;
#pragma unroll 8
    for (int i = 0; i < 32; ++i) { const float f0 = __builtin_nontemporal_load(src + (size_t)(2 * i) * N), f1 = __builtin_nontemporal_load(src + (size_t)(2 * i + 1) * N); scr[i * 65 + lane] = pk2(f0, f1); }
    LDS_WAIT(); asm volatile("" ::: "memory");
    const int c = lane & 7;
#pragma unroll
    for (int j = 0; j < 8; ++j) { const int n = (lane >> 3) + 8 * j; const LAS unsigned* s = scr + (4 * c) * 65 + n;
        v4u o; o.x = s[0]; o.y = s[65]; o.z = s[130]; o.w = s[195];
        *(GAS v4u*)(WT + (size_t)(dest_row0 + n) * Kd + k0 + 8 * c) = o; }
    LDS_WAIT(); asm volatile("" ::: "memory");
}

__device__ __forceinline__ void p0_prologue(const float* const* in, unsigned char* ws, LAS unsigned char* lds, int gw, int NGW, int tid, int lane, int wave) {
    const float* c_in = in[1]; const float* w_ada = in[2];
    LAS float* sc = (LAS float*)lds;
    for (int i = tid; i < 2 * D; i += NWAVES * 64) { const float v = c_in[i]; sc[i] = v / (1.0f + __expf(-v)); }
    __syncthreads();
    LAS unsigned* scr = (LAS unsigned*)(lds + 32768 + wave * 8320);
    float* PART = (float*)(ws + WS_PART);
    constexpr int GEMV_ITEMS = 192 * 32;
    constexpr int I_IN = 64 * 327, I_OR = 32 * 64, I_OC = 32 * 64, I_OUT = 64 * 64;
    constexpr int NITEMS = GEMV_ITEMS + I_IN + I_OR + I_OC + I_OUT;
    for (int it = gw; it < NITEMS; it += NGW) {
        int r = it;
        if (r < GEMV_ITEMS) {
            const int cg = r % 192, ks = r / 192, n0 = cg * 128 + lane * 2, k0 = ks * 128;
            f32x2 acc0 = {0.f, 0.f}, acc1 = {0.f, 0.f};
            const float* wp = w_ada + (size_t)k0 * NADA + n0;
#pragma unroll 8
            for (int k = 0; k < 128; ++k) { const f32x2 wv = __builtin_nontemporal_load((const f32x2*)(wp + (size_t)k * NADA)); const float s0 = sc[k0 + k], s1 = sc[D + k0 + k]; acc0 += wv * s0; acc1 += wv * s1; }
            float* p0 = PART + (size_t)(ks * 2 + 0) * NADA + n0; float* p1 = PART + (size_t)(ks * 2 + 1) * NADA + n0;
            __hip_atomic_store(p0, acc0.x, RLX_AGENT); __hip_atomic_store(p0 + 1, acc0.y, RLX_AGENT); __hip_atomic_store(p1, acc1.x, RLX_AGENT); __hip_atomic_store(p1 + 1, acc1.y, RLX_AGENT);
            asm volatile("s_waitcnt vmcnt(0)" ::: "memory");
            unsigned arrived = 0u;
            if (lane == 0) arrived = __hip_atomic_fetch_add((unsigned*)(ws + WS_CTL) + CW_MODCNT + cg, 1u, RLX_AGENT);
            arrived = (unsigned)__builtin_amdgcn_readfirstlane((int)arrived);
            if (arrived == 31u) {
                float* MOD = (float*)(ws + WS_MOD); const float* bp = in[3] + n0;
                float s00 = bp[0], s01 = bp[1], s10 = s00, s11 = s01;
#pragma unroll 8
                for (int q = 0; q < 32; ++q) { const float* r0 = PART + (size_t)(q * 2) * NADA + n0; const float* r1 = r0 + NADA;
                    s00 += __hip_atomic_load(r0, RLX_AGENT); s01 += __hip_atomic_load(r0 + 1, RLX_AGENT); s10 += __hip_atomic_load(r1, RLX_AGENT); s11 += __hip_atomic_load(r1 + 1, RLX_AGENT); }
                *(f32x2*)(MOD + n0) = (f32x2){s00, s01}; *(f32x2*)(MOD + NADA + n0) = (f32x2){s10, s11};
            }
            continue;
        }
        r -= GEMV_ITEMS;
        if (r < I_IN) { const int kb = r / 327, nb = r % 327, n0 = nb * 64; transpose_item(in[5], N_IN, D, (bf16*)(ws + WS_WIN), kb, nb, n0 + (n0 >= N_SHIFT ? 64 : 0), scr, lane); continue; }
        r -= I_IN;
        if (r < I_OR) { transpose_item(in[18], D, D, (bf16*)(ws + WS_WOCAT), r / 64, r % 64, (r % 64) * 64, scr, lane); continue; }
        r -= I_OR;
        if (r < I_OC) { transpose_item(in[19], D, D, (bf16*)(ws + WS_WOCAT) + DR, r / 64, r % 64, (r % 64) * 64, scr, lane); continue; }
        r -= I_OC;
        transpose_item(in[20], D, D, (bf16*)(ws + WS_WOUT), r / 64, r % 64, (r % 64) * 64, scr, lane);
    }
    const int gt = gw * 64 + lane, NT = NGW * 64;
    bf16* WL = (bf16*)(ws + WS_WLORA);
    for (int e = gt; e < 3 * 2048 * 256; e += NT) {
        const int seg = e / (2048 * 256), kk = (e / 2048) % 256, n = e % 2048;
        float v = 0.f;
        if (seg == 0) { if (kk < 96) v = in[12][(size_t)kk * 2048 + n]; }
        else if (seg == 1) { if (kk < 96) v = in[13][(size_t)kk * 2048 + n]; }
        else v = in[14][(size_t)kk * 2048 + n];
        WL[((size_t)seg * 2048 + n) * 256 + kk] = (bf16)f2bf(v);
    }
    GAS v4u* padp = (GAS v4u*)((bf16*)(ws + WS_WIN) + (size_t)N_SHIFT * D);
    for (int e = gt; e < 64 * D / 8; e += NT) padp[e] = (v4u){0u, 0u, 0u, 0u};
}

__device__ __forceinline__ void p0b_mod(const float* b_ada, unsigned char* ws, int gt, int NT) {
    const float* PART = (const float*)(ws + WS_PART); float* MOD = (float*)(ws + WS_MOD);
    for (int e = gt; e < 2 * NADA; e += NT) { const int b = e / NADA, n = e % NADA; float s = b_ada[n];
#pragma unroll 8
        for (int ks = 0; ks < 32; ++ks) s += PART[(size_t)(ks * 2 + b) * NADA + n];
        MOD[e] = s; }
}

template <bool ADD_D1>
__device__ __forceinline__ void norm_mod_rows(const float* src, const bf16* d1, const float* gain, const float* mod, int shift_off, int scale_off, bf16* dst, LAS unsigned char* lds, int gw, int NGW, int tid, int lane) {
    asm volatile("" : "+v"(tid), "+v"(lane));
    LAS f32x4* gsl = (LAS f32x4*)lds; LAS f32x4* shl = (LAS f32x4*)(lds + 16384);
    for (int b = 0; b < BATCH; ++b) {
        __syncthreads();
        for (int c4 = tid; c4 < D / 4; c4 += NWAVES * 64) { const f32x4 g = *(const f32x4*)(gain + 4 * c4), s = *(const f32x4*)(mod + (size_t)b * NADA + scale_off + 4 * c4);
            gsl[c4] = g * (s + 1.0f); shl[c4] = *(const f32x4*)(mod + (size_t)b * NADA + shift_off + 4 * c4); }
        __syncthreads();
        for (int m = b * T + gw; m < (b + 1) * T; m += NGW) {
            const GAS f32x4* xr = (const GAS f32x4*)(src + (size_t)m * D) + lane;
            f32x4 v[16];
#pragma unroll
            for (int j = 0; j < 16; ++j) v[j] = __builtin_nontemporal_load(xr + 64 * j);
            asm volatile("" : "+v"(v[0]), "+v"(v[1]), "+v"(v[2]), "+v"(v[3]), "+v"(v[4]), "+v"(v[5]), "+v"(v[6]), "+v"(v[7]), "+v"(v[8]), "+v"(v[9]), "+v"(v[10]), "+v"(v[11]), "+v"(v[12]), "+v"(v[13]), "+v"(v[14]), "+v"(v[15]));
            if (ADD_D1) { const GAS v2u* dr = (const GAS v2u*)(d1 + (size_t)m * D) + lane; v2u dv[16];
#pragma unroll
                for (int j = 0; j < 16; ++j) dv[j] = dr[64 * j];
#pragma unroll
                for (int j = 0; j < 16; ++j) v[j] += (f32x4){bflo(dv[j].x), bfhi(dv[j].x), bflo(dv[j].y), bfhi(dv[j].y)}; }
            float ss = 0.f;
#pragma unroll
            for (int j = 0; j < 16; ++j) ss += (v[j].x * v[j].x + v[j].y * v[j].y) + (v[j].z * v[j].z + v[j].w * v[j].w);
            const float rstd = __builtin_amdgcn_rsqf(wave_sum(ss) * (1.0f / D) + NORM_EPS);
            GAS v2u* o8 = (GAS v2u*)(dst + (size_t)m * D) + lane;
#pragma unroll
            for (int j = 0; j < 16; ++j) { const f32x4 h = v[j] * rstd * gsl[lane + 64 * j] + shl[lane + 64 * j]; v2u w; w.x = pk2(h.x, h.y); w.y = pk2(h.z, h.w); o8[64 * j] = w; }
        }
    }
    __syncthreads();
}

__device__ __forceinline__ void final_norm_rows(const float* x, const bf16* d12, float* out, const float* gain, LAS unsigned char* lds, int gw, int NGW, int tid, int lane) {
    asm volatile("" : "+v"(tid), "+v"(lane));
    LAS f32x4* gsl = (LAS f32x4*)lds;
    for (int c4 = tid; c4 < D / 4; c4 += NWAVES * 64) gsl[c4] = *(const f32x4*)(gain + 4 * c4);
    __syncthreads();
    for (int m = gw; m < M; m += NGW) {
        const GAS f32x4* xr = (const GAS f32x4*)(x + (size_t)m * D) + lane; const GAS v2u* ar = (const GAS v2u*)(d12 + (size_t)m * D) + lane;
        f32x4 v[16]; v2u da[16];
#pragma unroll
        for (int j = 0; j < 16; ++j) { v[j] = __builtin_nontemporal_load(xr + 64 * j); da[j] = __builtin_nontemporal_load(ar + 64 * j); }
        asm volatile("" : "+v"(v[0]), "+v"(v[1]), "+v"(v[2]), "+v"(v[3]), "+v"(v[4]), "+v"(v[5]), "+v"(v[6]), "+v"(v[7]), "+v"(v[8]), "+v"(v[9]), "+v"(v[10]), "+v"(v[11]), "+v"(v[12]), "+v"(v[13]), "+v"(v[14]), "+v"(v[15]));
        float ss = 0.f;
#pragma unroll
        for (int j = 0; j < 16; ++j) { v[j] += (f32x4){bflo(da[j].x), bfhi(da[j].x), bflo(da[j].y), bfhi(da[j].y)};
            ss += (v[j].x * v[j].x + v[j].y * v[j].y) + (v[j].z * v[j].z + v[j].w * v[j].w); }
        const float rstd = __builtin_amdgcn_rsqf(wave_sum(ss) * (1.0f / D) + NORM_EPS);
        GAS f32x4* orow = (GAS f32x4*)(out + (size_t)m * D) + lane;
#pragma unroll
        for (int j = 0; j < 16; ++j) __builtin_nontemporal_store(v[j] * rstd * gsl[lane + 64 * j], orow + 64 * j);
    }
}

__device__ __forceinline__ void p3_prep(const float* mu, const float* convw, unsigned char* ws, int gw, int NGW, int lane) {
    const bf16* PS = (const bf16*)(ws + WS_PS); const bf16* PC = (const bf16*)(ws + WS_PC);
    bf16* AL = (bf16*)(ws + WS_ALORA); bf16* CB = (bf16*)(ws + WS_OCB) + DR;
    constexpr int TB = 32, PD = 4;
    for (int item = gw; item < 4 * (M / TB); item += NGW) {
        const int q = item & 3, m0 = (item >> 2) * TB, t0 = m0 % T;
        const int c8 = (q * 64 + lane) * 8;
        f32x4 w[3][2];
#pragma unroll
        for (int k = 0; k < 3; ++k) { w[k][0] = *(const f32x4*)(convw + k * 2048 + c8); w[k][1] = *(const f32x4*)(convw + k * 2048 + c8 + 4); }
        const int seg = q < 2 ? q : 2, kkA = (q == 3 ? 128 : 0) + lane, kkB = kkA + 64;
        const int colA = (seg == 0 ? 6144 : (seg == 1 ? 6240 : 6336)) + kkA, colB = colA + 64;
        const bool actB = seg == 2 || kkB < 96;
        const float muA = mu[colA], muB = actB ? mu[colB] : 0.f;
        float z1[8], z2[8], pA = 0.f, pB = 0.f;
#pragma unroll
        for (int e = 0; e < 8; ++e) { z1[e] = 0.f; z2[e] = 0.f; }
        if (t0 != 0) {
            const bf16* r1 = PC + (size_t)(m0 - 1) * LD_PC; const bf16* r2 = r1 - LD_PC;
            const v4u c1 = *(const GAS v4u*)(r1 + 2048 + c8), x1 = *(const GAS v4u*)(r1 + 4096 + c8), c2 = *(const GAS v4u*)(r2 + 2048 + c8), x2 = *(const GAS v4u*)(r2 + 4096 + c8);
            z1[0] = bflo(c1.x) * bflo(x1.x); z1[1] = bfhi(c1.x) * bfhi(x1.x); z1[2] = bflo(c1.y) * bflo(x1.y); z1[3] = bfhi(c1.y) * bfhi(x1.y);
            z1[4] = bflo(c1.z) * bflo(x1.z); z1[5] = bfhi(c1.z) * bfhi(x1.z); z1[6] = bflo(c1.w) * bflo(x1.w); z1[7] = bfhi(c1.w) * bfhi(x1.w);
            z2[0] = bflo(c2.x) * bflo(x2.x); z2[1] = bfhi(c2.x) * bfhi(x2.x); z2[2] = bflo(c2.y) * bflo(x2.y); z2[3] = bfhi(c2.y) * bfhi(x2.y);
            z2[4] = bflo(c2.z) * bflo(x2.z); z2[5] = bfhi(c2.z) * bfhi(x2.z); z2[6] = bflo(c2.w) * bflo(x2.w); z2[7] = bfhi(c2.w) * bfhi(x2.w);
            const bf16* ps1 = PS + (size_t)(m0 - 1) * LD_PS; pA = bf1(ps1[colA]); pB = actB ? bf1(ps1[colB]) : 0.f;
        }
        v4u ncc[PD], ncx[PD], ncb[PD]; bf16 nla[PD], nlb[PD];
#pragma unroll
        for (int d = 0; d < PD; ++d) { const bf16* r = PC + (size_t)(m0 + d) * LD_PC; ncb[d] = __builtin_nontemporal_load((const GAS v4u*)(r + c8)); ncc[d] = __builtin_nontemporal_load((const GAS v4u*)(r + 2048 + c8)); ncx[d] = __builtin_nontemporal_load((const GAS v4u*)(r + 4096 + c8));
            const bf16* ps = PS + (size_t)(m0 + d) * LD_PS; nla[d] = ps[colA]; nlb[d] = actB ? ps[colB] : (bf16)0; }
        for (int i0 = 0; i0 < TB; i0 += PD) {
#pragma unroll
            for (int d = 0; d < PD; ++d) {
                const int m = m0 + i0 + d;
                const v4u cc = ncc[d], cx = ncx[d], cb = ncb[d]; const float cA = bf1(nla[d]), cB = bf1(nlb[d]);
                { const int mn = m0 + (i0 + d + PD < TB ? i0 + d + PD : TB - 1); const bf16* r = PC + (size_t)mn * LD_PC; ncb[d] = __builtin_nontemporal_load((const GAS v4u*)(r + c8)); ncc[d] = __builtin_nontemporal_load((const GAS v4u*)(r + 2048 + c8)); ncx[d] = __builtin_nontemporal_load((const GAS v4u*)(r + 4096 + c8));
                  const bf16* ps = PS + (size_t)mn * LD_PS; nla[d] = ps[colA]; nlb[d] = actB ? ps[colB] : (bf16)0; }
                float z[8];
                z[0] = bflo(cc.x) * bflo(cx.x); z[1] = bfhi(cc.x) * bfhi(cx.x); z[2] = bflo(cc.y) * bflo(cx.y); z[3] = bfhi(cc.y) * bfhi(cx.y);
                z[4] = bflo(cc.z) * bflo(cx.z); z[5] = bfhi(cc.z) * bfhi(cx.z); z[6] = bflo(cc.w) * bflo(cx.w); z[7] = bfhi(cc.w) * bfhi(cx.w);
                float y[8];
#pragma unroll
                for (int e = 0; e < 8; ++e) { y[e] = w[2][e >> 2][e & 3] * z[e] + w[1][e >> 2][e & 3] * z1[e] + w[0][e >> 2][e & 3] * z2[e]; z2[e] = z1[e]; z1[e] = z[e]; }
                v4u o; o.x = pk2(bflo(cb.x) * y[0], bfhi(cb.x) * y[1]); o.y = pk2(bflo(cb.y) * y[2], bfhi(cb.y) * y[3]); o.z = pk2(bflo(cb.z) * y[4], bfhi(cb.z) * y[5]); o.w = pk2(bflo(cb.w) * y[6], bfhi(cb.w) * y[7]);
                *(GAS v4u*)(CB + (size_t)m * D + c8) = o;
                const float sA = cA + (pA - cA) * muA, sB = cB + (pB - cB) * muB; pA = cA; pB = cB;
                float vA, vB;
                if (seg == 0) { vA = 1.0f - 2.0f * __builtin_amdgcn_rcpf(1.0f + __expf(2.0f * sA)); vB = 1.0f - 2.0f * __builtin_amdgcn_rcpf(1.0f + __expf(2.0f * sB)); }
                else if (seg == 1) { vA = sA; vB = sB; }
                else { vA = sigm(sA); vB = sigm(sB); }
                bf16* al = AL + ((size_t)seg * M + m) * 256;
                al[kkA] = (bf16)f2bf(vA); al[kkB] = actB ? (bf16)f2bf(vB) : (bf16)0;
                if (q < 2) { al[128 + lane] = (bf16)0; al[192 + lane] = (bf16)0; }
            }
        }
    }
}

__device__ __forceinline__ void p5_scanprep(const float* mu, const float* k_k, const float* k_a, const float* r_k, unsigned char* ws, float* dout, int gw, int NGW, int lane) {
    const bf16* PS = (const bf16*)(ws + WS_PS); const bf16* ICLR = (const bf16*)(ws + WS_ICLR); float* WDio = (float*)(ws + WS_WD);
    float* Ro = (float*)(ws + WS_R); float* Ko = (float*)(ws + WS_KK); float* Vo = dout; float* Ao = dout + (size_t)M * DR; float* Bo = (float*)(ws + WS_BV); float* BON = (float*)(ws + WS_BONUS); float* CEND = (float*)(ws + WS_CEND);
    for (int item = gw; item < 8 * (M / 64); item += NGW) {
        const int cg = item & 7, tb = item >> 3, c0 = cg * 256 + lane * 4;
        const f32x4 mur = *(const f32x4*)(mu + c0), muk = *(const f32x4*)(mu + 2048 + c0), muv = *(const f32x4*)(mu + 4096 + c0);
        const f32x4 kkw = *(const f32x4*)(k_k + c0), kaw = *(const f32x4*)(k_a + c0), rkw = *(const f32x4*)(r_k + c0);
        const int m0 = tb * 64;
        const size_t ovh = ((size_t)((m0 / T) * NH + cg * 4 + (lane >> 4)) * T + (m0 % T)) * 64 + (lane & 15) * 4;
        f32x4 pr = {0.f, 0.f, 0.f, 0.f}, pk = pr, pv = pr, cum = {1.f, 1.f, 1.f, 1.f};
        if ((m0 % T) != 0) { const bf16* p = PS + (size_t)(m0 - 1) * LD_PS + c0;
            const v2u a = *(const GAS v2u*)p, b = *(const GAS v2u*)(p + 2048), c = *(const GAS v2u*)(p + 4096);
            pr = (f32x4){bflo(a.x), bfhi(a.x), bflo(a.y), bfhi(a.y)}; pk = (f32x4){bflo(b.x), bfhi(b.x), bflo(b.y), bfhi(b.y)}; pv = (f32x4){bflo(c.x), bfhi(c.x), bflo(c.y), bfhi(c.y)}; }
        v2u na, nb, nc, nicp; f32x4 nwp;
        { const bf16* p = PS + (size_t)m0 * LD_PS + c0; na = *(const GAS v2u*)p; nb = *(const GAS v2u*)(p + 2048); nc = *(const GAS v2u*)(p + 4096);
          nicp = *(const GAS v2u*)(ICLR + (size_t)m0 * DR + c0); nwp = *(const f32x4*)(WDio + (size_t)m0 * DR + c0); }
#pragma unroll 2
        for (int i = 0; i < 64; ++i) {
            const int m = m0 + i;
            const v2u a = na, b = nb, c = nc, icp = nicp; const f32x4 wp = nwp;
            { const int mn = m0 + (i < 63 ? i + 1 : 63); const bf16* p = PS + (size_t)mn * LD_PS + c0; na = __builtin_nontemporal_load((const GAS v2u*)p); nb = __builtin_nontemporal_load((const GAS v2u*)(p + 2048)); nc = __builtin_nontemporal_load((const GAS v2u*)(p + 4096));
              nicp = __builtin_nontemporal_load((const GAS v2u*)(ICLR + (size_t)mn * DR + c0)); nwp = __builtin_nontemporal_load((const f32x4*)(WDio + (size_t)mn * DR + c0)); }
            const f32x4 cr = (f32x4){bflo(a.x), bfhi(a.x), bflo(a.y), bfhi(a.y)}, ck = (f32x4){bflo(b.x), bfhi(b.x), bflo(b.y), bfhi(b.y)}, cv = (f32x4){bflo(c.x), bfhi(c.x), bflo(c.y), bfhi(c.y)};
            const f32x4 ic = (f32x4){bflo(icp.x), bfhi(icp.x), bflo(icp.y), bfhi(icp.y)};
            f32x4 dec;
#pragma unroll
            for (int e = 0; e < 4; ++e) { const float z = -wp[e]; const float sp = fmaxf(z, 0.f) + __logf(1.0f + __expf(-fabsf(z))); dec[e] = __expf(-__expf(-sp - 0.5f)); }
            const f32x4 cprev = cum; cum = cum * dec;
            const f32x4 cinv = (f32x4){__builtin_amdgcn_rcpf(cum.x), __builtin_amdgcn_rcpf(cum.y), __builtin_amdgcn_rcpf(cum.z), __builtin_amdgcn_rcpf(cum.w)};
            const f32x4 r = cr + (pr - cr) * mur, kr = ck + (pk - ck) * muk, v = cv + (pv - cv) * muv;
            pr = cr; pk = ck; pv = cv;
            const f32x4 kkv = kr * kkw;
            float ss = (kkv.x * kkv.x + kkv.y * kkv.y) + (kkv.z * kkv.z + kkv.w * kkv.w);
            ss += __shfl_xor(ss, 1); ss += __shfl_xor(ss, 2); ss += __shfl_xor(ss, 4); ss += __shfl_xor(ss, 8);
            const float inv = __builtin_amdgcn_rsqf(fmaxf(ss, 1e-24f));
            const f32x4 kk = kkv * inv;
            const f32x4 k = kr * ((ic - 1.0f) * kaw + 1.0f);
            float bs = (r.x * k.x * rkw.x + r.y * k.y * rkw.y) + (r.z * k.z * rkw.z + r.w * k.w * rkw.w);
            bs += __shfl_xor(bs, 1); bs += __shfl_xor(bs, 2); bs += __shfl_xor(bs, 4); bs += __shfl_xor(bs, 8);
            const size_t o = (size_t)m * DR + c0;
            __builtin_nontemporal_store(r * cum, (f32x4*)(Ro + o)); __builtin_nontemporal_store(k * cinv, (f32x4*)(Ko + o)); { v2u vw; vw.x = pk2(v.x, v.y); vw.y = pk2(v.z, v.w); __builtin_nontemporal_store(vw, (GAS v2u*)((bf16*)Vo + ovh + (size_t)i * 64)); } __builtin_nontemporal_store(-kk * cprev, (f32x4*)(Ao + o)); __builtin_nontemporal_store(kk * ic * cinv, (f32x4*)(Bo + o));
            if ((lane & 15) == 0) BON[(size_t)m * NH + cg * 4 + (lane >> 4)] = bs;
        }
        *(f32x4*)(CEND + (size_t)tb * DR + c0) = cum;
    }
}

#define SCAN_SA16(s0, s1, s2, s3, av, S, B) asm volatile( \
        "s_nop 1\n\t" \
        "v_fmac_f32_dpp %0, %4, %5 row_newbcast:0 row_mask:0xf bank_mask:0xf\n\t" \
        "v_fmac_f32_dpp %1, %4, %6 row_newbcast:1 row_mask:0xf bank_mask:0xf\n\t" \
        "v_fmac_f32_dpp %2, %4, %7 row_newbcast:2 row_mask:0xf bank_mask:0xf\n\t" \
        "v_fmac_f32_dpp %3, %4, %8 row_newbcast:3 row_mask:0xf bank_mask:0xf\n\t" \
        "v_fmac_f32_dpp %0, %4, %9 row_newbcast:4 row_mask:0xf bank_mask:0xf\n\t" \
        "v_fmac_f32_dpp %1, %4, %10 row_newbcast:5 row_mask:0xf bank_mask:0xf\n\t" \
        "v_fmac_f32_dpp %2, %4, %11 row_newbcast:6 row_mask:0xf bank_mask:0xf\n\t" \
        "v_fmac_f32_dpp %3, %4, %12 row_newbcast:7 row_mask:0xf bank_mask:0xf\n\t" \
        "v_fmac_f32_dpp %0, %4, %13 row_newbcast:8 row_mask:0xf bank_mask:0xf\n\t" \
        "v_fmac_f32_dpp %1, %4, %14 row_newbcast:9 row_mask:0xf bank_mask:0xf\n\t" \
        "v_fmac_f32_dpp %2, %4, %15 row_newbcast:10 row_mask:0xf bank_mask:0xf\n\t" \
        "v_fmac_f32_dpp %3, %4, %16 row_newbcast:11 row_mask:0xf bank_mask:0xf\n\t" \
        "v_fmac_f32_dpp %0, %4, %17 row_newbcast:12 row_mask:0xf bank_mask:0xf\n\t" \
        "v_fmac_f32_dpp %1, %4, %18 row_newbcast:13 row_mask:0xf bank_mask:0xf\n\t" \
        "v_fmac_f32_dpp %2, %4, %19 row_newbcast:14 row_mask:0xf bank_mask:0xf\n\t" \
        "v_fmac_f32_dpp %3, %4, %20 row_newbcast:15 row_mask:0xf bank_mask:0xf\n\t" \
        : "+v"(s0), "+v"(s1), "+v"(s2), "+v"(s3) : "v"(av), "v"(S[(B)+0]), "v"(S[(B)+1]), "v"(S[(B)+2]), "v"(S[(B)+3]), "v"(S[(B)+4]), "v"(S[(B)+5]), "v"(S[(B)+6]), "v"(S[(B)+7]), "v"(S[(B)+8]), "v"(S[(B)+9]), "v"(S[(B)+10]), "v"(S[(B)+11]), "v"(S[(B)+12]), "v"(S[(B)+13]), "v"(S[(B)+14]), "v"(S[(B)+15]))
#define SCAN_SA16X(s0, s1, s2, s3, av, S, E) asm volatile( \
        "s_nop 1\n\t" \
        "v_fmac_f32_dpp %0, %4, %5 row_newbcast:0 row_mask:0xf bank_mask:0xf\n\t" \
        "v_fmac_f32_dpp %1, %4, %6 row_newbcast:1 row_mask:0xf bank_mask:0xf\n\t" \
        "v_fmac_f32_dpp %2, %4, %7 row_newbcast:2 row_mask:0xf bank_mask:0xf\n\t" \
        "v_fmac_f32_dpp %3, %4, %8 row_newbcast:3 row_mask:0xf bank_mask:0xf\n\t" \
        "v_fmac_f32_dpp %0, %4, %9 row_newbcast:4 row_mask:0xf bank_mask:0xf\n\t" \
        "v_fmac_f32_dpp %1, %4, %10 row_newbcast:5 row_mask:0xf bank_mask:0xf\n\t" \
        "v_fmac_f32_dpp %2, %4, %11 row_newbcast:6 row_mask:0xf bank_mask:0xf\n\t" \
        "v_fmac_f32_dpp %3, %4, %12 row_newbcast:7 row_mask:0xf bank_mask:0xf\n\t" \
        "v_fmac_f32_dpp %0, %4, %13 row_newbcast:8 row_mask:0xf bank_mask:0xf\n\t" \
        "v_fmac_f32_dpp %1, %4, %14 row_newbcast:9 row_mask:0xf bank_mask:0xf\n\t" \
        "v_fmac_f32_dpp %2, %4, %15 row_newbcast:10 row_mask:0xf bank_mask:0xf\n\t" \
        "v_fmac_f32_dpp %3, %4, %16 row_newbcast:11 row_mask:0xf bank_mask:0xf\n\t" \
        "v_fmac_f32_dpp %0, %4, %17 row_newbcast:12 row_mask:0xf bank_mask:0xf\n\t" \
        "v_fmac_f32_dpp %1, %4, %18 row_newbcast:13 row_mask:0xf bank_mask:0xf\n\t" \
        "v_fmac_f32_dpp %2, %4, %19 row_newbcast:14 row_mask:0xf bank_mask:0xf\n\t" \
        "v_fmac_f32_dpp %3, %4, %20 row_newbcast:15 row_mask:0xf bank_mask:0xf\n\t" \
        : "+v"(s0), "+v"(s1), "+v"(s2), "+v"(s3) : "v"(av), "v"(S[4*0+(E)]), "v"(S[4*1+(E)]), "v"(S[4*2+(E)]), "v"(S[4*3+(E)]), "v"(S[4*4+(E)]), "v"(S[4*5+(E)]), "v"(S[4*6+(E)]), "v"(S[4*7+(E)]), "v"(S[4*8+(E)]), "v"(S[4*9+(E)]), "v"(S[4*10+(E)]), "v"(S[4*11+(E)]), "v"(S[4*12+(E)]), "v"(S[4*13+(E)]), "v"(S[4*14+(E)]), "v"(S[4*15+(E)]))
#define SCAN_UPD16_P(S, B, wv, bv, sa) asm volatile( \
        "s_nop 1\n\t" \
        "v_mul_f32_dpp %0, %16, %0 row_newbcast:0 row_mask:0xf bank_mask:0xf\n\t" \
        "v_mul_f32_dpp %1, %16, %1 row_newbcast:1 row_mask:0xf bank_mask:0xf\n\t" \
        "v_mul_f32_dpp %2, %16, %2 row_newbcast:2 row_mask:0xf bank_mask:0xf\n\t" \
        "v_mul_f32_dpp %3, %16, %3 row_newbcast:3 row_mask:0xf bank_mask:0xf\n\t" \
        "v_mul_f32_dpp %4, %16, %4 row_newbcast:4 row_mask:0xf bank_mask:0xf\n\t" \
        "v_mul_f32_dpp %5, %16, %5 row_newbcast:5 row_mask:0xf bank_mask:0xf\n\t" \
        "v_mul_f32_dpp %6, %16, %6 row_newbcast:6 row_mask:0xf bank_mask:0xf\n\t" \
        "v_mul_f32_dpp %7, %16, %7 row_newbcast:7 row_mask:0xf bank_mask:0xf\n\t" \
        "v_mul_f32_dpp %8, %16, %8 row_newbcast:8 row_mask:0xf bank_mask:0xf\n\t" \
        "v_mul_f32_dpp %9, %16, %9 row_newbcast:9 row_mask:0xf bank_mask:0xf\n\t" \
        "v_mul_f32_dpp %10, %16, %10 row_newbcast:10 row_mask:0xf bank_mask:0xf\n\t" \
        "v_mul_f32_dpp %11, %16, %11 row_newbcast:11 row_mask:0xf bank_mask:0xf\n\t" \
        "v_mul_f32_dpp %12, %16, %12 row_newbcast:12 row_mask:0xf bank_mask:0xf\n\t" \
        "v_mul_f32_dpp %13, %16, %13 row_newbcast:13 row_mask:0xf bank_mask:0xf\n\t" \
        "v_mul_f32_dpp %14, %16, %14 row_newbcast:14 row_mask:0xf bank_mask:0xf\n\t" \
        "v_mul_f32_dpp %15, %16, %15 row_newbcast:15 row_mask:0xf bank_mask:0xf\n\t" \
        "v_fmac_f32_dpp %0, %17, %18 row_newbcast:0 row_mask:0xf bank_mask:0xf\n\t" \
        "v_fmac_f32_dpp %1, %17, %18 row_newbcast:1 row_mask:0xf bank_mask:0xf\n\t" \
        "v_fmac_f32_dpp %2, %17, %18 row_newbcast:2 row_mask:0xf bank_mask:0xf\n\t" \
        "v_fmac_f32_dpp %3, %17, %18 row_newbcast:3 row_mask:0xf bank_mask:0xf\n\t" \
        "v_fmac_f32_dpp %4, %17, %18 row_newbcast:4 row_mask:0xf bank_mask:0xf\n\t" \
        "v_fmac_f32_dpp %5, %17, %18 row_newbcast:5 row_mask:0xf bank_mask:0xf\n\t" \
        "v_fmac_f32_dpp %6, %17, %18 row_newbcast:6 row_mask:0xf bank_mask:0xf\n\t" \
        "v_fmac_f32_dpp %7, %17, %18 row_newbcast:7 row_mask:0xf bank_mask:0xf\n\t" \
        "v_fmac_f32_dpp %8, %17, %18 row_newbcast:8 row_mask:0xf bank_mask:0xf\n\t" \
        "v_fmac_f32_dpp %9, %17, %18 row_newbcast:9 row_mask:0xf bank_mask:0xf\n\t" \
        "v_fmac_f32_dpp %10, %17, %18 row_newbcast:10 row_mask:0xf bank_mask:0xf\n\t" \
        "v_fmac_f32_dpp %11, %17, %18 row_newbcast:11 row_mask:0xf bank_mask:0xf\n\t" \
        "v_fmac_f32_dpp %12, %17, %18 row_newbcast:12 row_mask:0xf bank_mask:0xf\n\t" \
        "v_fmac_f32_dpp %13, %17, %18 row_newbcast:13 row_mask:0xf bank_mask:0xf\n\t" \
        "v_fmac_f32_dpp %14, %17, %18 row_newbcast:14 row_mask:0xf bank_mask:0xf\n\t" \
        "v_fmac_f32_dpp %15, %17, %18 row_newbcast:15 row_mask:0xf bank_mask:0xf\n\t" \
        : "+v"(S[(B)+0]), "+v"(S[(B)+1]), "+v"(S[(B)+2]), "+v"(S[(B)+3]), "+v"(S[(B)+4]), "+v"(S[(B)+5]), "+v"(S[(B)+6]), "+v"(S[(B)+7]), "+v"(S[(B)+8]), "+v"(S[(B)+9]), "+v"(S[(B)+10]), "+v"(S[(B)+11]), "+v"(S[(B)+12]), "+v"(S[(B)+13]), "+v"(S[(B)+14]), "+v"(S[(B)+15]) : "v"(wv), "v"(bv), "v"(sa))
#define SCAN_UPD16_Q(S, B, wv, bv, sa, kv, vv) asm volatile( \
        "s_nop 1\n\t" \
        "v_mul_f32_dpp %0, %16, %0 row_newbcast:0 row_mask:0xf bank_mask:0xf\n\t" \
        "v_mul_f32_dpp %1, %16, %1 row_newbcast:1 row_mask:0xf bank_mask:0xf\n\t" \
        "v_mul_f32_dpp %2, %16, %2 row_newbcast:2 row_mask:0xf bank_mask:0xf\n\t" \
        "v_mul_f32_dpp %3, %16, %3 row_newbcast:3 row_mask:0xf bank_mask:0xf\n\t" \
        "v_mul_f32_dpp %4, %16, %4 row_newbcast:4 row_mask:0xf bank_mask:0xf\n\t" \
        "v_mul_f32_dpp %5, %16, %5 row_newbcast:5 row_mask:0xf bank_mask:0xf\n\t" \
        "v_mul_f32_dpp %6, %16, %6 row_newbcast:6 row_mask:0xf bank_mask:0xf\n\t" \
        "v_mul_f32_dpp %7, %16, %7 row_newbcast:7 row_mask:0xf bank_mask:0xf\n\t" \
        "v_mul_f32_dpp %8, %16, %8 row_newbcast:8 row_mask:0xf bank_mask:0xf\n\t" \
        "v_mul_f32_dpp %9, %16, %9 row_newbcast:9 row_mask:0xf bank_mask:0xf\n\t" \
        "v_mul_f32_dpp %10, %16, %10 row_newbcast:10 row_mask:0xf bank_mask:0xf\n\t" \
        "v_mul_f32_dpp %11, %16, %11 row_newbcast:11 row_mask:0xf bank_mask:0xf\n\t" \
        "v_mul_f32_dpp %12, %16, %12 row_newbcast:12 row_mask:0xf bank_mask:0xf\n\t" \
        "v_mul_f32_dpp %13, %16, %13 row_newbcast:13 row_mask:0xf bank_mask:0xf\n\t" \
        "v_mul_f32_dpp %14, %16, %14 row_newbcast:14 row_mask:0xf bank_mask:0xf\n\t" \
        "v_mul_f32_dpp %15, %16, %15 row_newbcast:15 row_mask:0xf bank_mask:0xf\n\t" \
        "v_fmac_f32_dpp %0, %17, %18 row_newbcast:0 row_mask:0xf bank_mask:0xf\n\t" \
        "v_fmac_f32_dpp %1, %17, %18 row_newbcast:1 row_mask:0xf bank_mask:0xf\n\t" \
        "v_fmac_f32_dpp %2, %17, %18 row_newbcast:2 row_mask:0xf bank_mask:0xf\n\t" \
        "v_fmac_f32_dpp %3, %17, %18 row_newbcast:3 row_mask:0xf bank_mask:0xf\n\t" \
        "v_fmac_f32_dpp %4, %17, %18 row_newbcast:4 row_mask:0xf bank_mask:0xf\n\t" \
        "v_fmac_f32_dpp %5, %17, %18 row_newbcast:5 row_mask:0xf bank_mask:0xf\n\t" \
        "v_fmac_f32_dpp %6, %17, %18 row_newbcast:6 row_mask:0xf bank_mask:0xf\n\t" \
        "v_fmac_f32_dpp %7, %17, %18 row_newbcast:7 row_mask:0xf bank_mask:0xf\n\t" \
        "v_fmac_f32_dpp %8, %17, %18 row_newbcast:8 row_mask:0xf bank_mask:0xf\n\t" \
        "v_fmac_f32_dpp %9, %17, %18 row_newbcast:9 row_mask:0xf bank_mask:0xf\n\t" \
        "v_fmac_f32_dpp %10, %17, %18 row_newbcast:10 row_mask:0xf bank_mask:0xf\n\t" \
        "v_fmac_f32_dpp %11, %17, %18 row_newbcast:11 row_mask:0xf bank_mask:0xf\n\t" \
        "v_fmac_f32_dpp %12, %17, %18 row_newbcast:12 row_mask:0xf bank_mask:0xf\n\t" \
        "v_fmac_f32_dpp %13, %17, %18 row_newbcast:13 row_mask:0xf bank_mask:0xf\n\t" \
        "v_fmac_f32_dpp %14, %17, %18 row_newbcast:14 row_mask:0xf bank_mask:0xf\n\t" \
        "v_fmac_f32_dpp %15, %17, %18 row_newbcast:15 row_mask:0xf bank_mask:0xf\n\t" \
        "v_fmac_f32_dpp %0, %19, %20 row_newbcast:0 row_mask:0xf bank_mask:0xf\n\t" \
        "v_fmac_f32_dpp %1, %19, %20 row_newbcast:1 row_mask:0xf bank_mask:0xf\n\t" \
        "v_fmac_f32_dpp %2, %19, %20 row_newbcast:2 row_mask:0xf bank_mask:0xf\n\t" \
        "v_fmac_f32_dpp %3, %19, %20 row_newbcast:3 row_mask:0xf bank_mask:0xf\n\t" \
        "v_fmac_f32_dpp %4, %19, %20 row_newbcast:4 row_mask:0xf bank_mask:0xf\n\t" \
        "v_fmac_f32_dpp %5, %19, %20 row_newbcast:5 row_mask:0xf bank_mask:0xf\n\t" \
        "v_fmac_f32_dpp %6, %19, %20 row_newbcast:6 row_mask:0xf bank_mask:0xf\n\t" \
        "v_fmac_f32_dpp %7, %19, %20 row_newbcast:7 row_mask:0xf bank_mask:0xf\n\t" \
        "v_fmac_f32_dpp %8, %19, %20 row_newbcast:8 row_mask:0xf bank_mask:0xf\n\t" \
        "v_fmac_f32_dpp %9, %19, %20 row_newbcast:9 row_mask:0xf bank_mask:0xf\n\t" \
        "v_fmac_f32_dpp %10, %19, %20 row_newbcast:10 row_mask:0xf bank_mask:0xf\n\t" \
        "v_fmac_f32_dpp %11, %19, %20 row_newbcast:11 row_mask:0xf bank_mask:0xf\n\t" \
        "v_fmac_f32_dpp %12, %19, %20 row_newbcast:12 row_mask:0xf bank_mask:0xf\n\t" \
        "v_fmac_f32_dpp %13, %19, %20 row_newbcast:13 row_mask:0xf bank_mask:0xf\n\t" \
        "v_fmac_f32_dpp %14, %19, %20 row_newbcast:14 row_mask:0xf bank_mask:0xf\n\t" \
        "v_fmac_f32_dpp %15, %19, %20 row_newbcast:15 row_mask:0xf bank_mask:0xf\n\t" \
        : "+v"(S[(B)+0]), "+v"(S[(B)+1]), "+v"(S[(B)+2]), "+v"(S[(B)+3]), "+v"(S[(B)+4]), "+v"(S[(B)+5]), "+v"(S[(B)+6]), "+v"(S[(B)+7]), "+v"(S[(B)+8]), "+v"(S[(B)+9]), "+v"(S[(B)+10]), "+v"(S[(B)+11]), "+v"(S[(B)+12]), "+v"(S[(B)+13]), "+v"(S[(B)+14]), "+v"(S[(B)+15]) : "v"(wv), "v"(bv), "v"(sa), "v"(kv), "v"(vv))
#define SCAN_UPD16_Y(S, B, wv, bv, sa, kv, vv, rv, y0, y1) asm volatile( \
        "s_nop 1\n\t" \
        "v_mul_f32_dpp %0, %18, %0 row_newbcast:0 row_mask:0xf bank_mask:0xf\n\t" \
        "v_mul_f32_dpp %1, %18, %1 row_newbcast:1 row_mask:0xf bank_mask:0xf\n\t" \
        "v_mul_f32_dpp %2, %18, %2 row_newbcast:2 row_mask:0xf bank_mask:0xf\n\t" \
        "v_mul_f32_dpp %3, %18, %3 row_newbcast:3 row_mask:0xf bank_mask:0xf\n\t" \
        "v_mul_f32_dpp %4, %18, %4 row_newbcast:4 row_mask:0xf bank_mask:0xf\n\t" \
        "v_mul_f32_dpp %5, %18, %5 row_newbcast:5 row_mask:0xf bank_mask:0xf\n\t" \
        "v_mul_f32_dpp %6, %18, %6 row_newbcast:6 row_mask:0xf bank_mask:0xf\n\t" \
        "v_mul_f32_dpp %7, %18, %7 row_newbcast:7 row_mask:0xf bank_mask:0xf\n\t" \
        "v_mul_f32_dpp %8, %18, %8 row_newbcast:8 row_mask:0xf bank_mask:0xf\n\t" \
        "v_mul_f32_dpp %9, %18, %9 row_newbcast:9 row_mask:0xf bank_mask:0xf\n\t" \
        "v_mul_f32_dpp %10, %18, %10 row_newbcast:10 row_mask:0xf bank_mask:0xf\n\t" \
        "v_mul_f32_dpp %11, %18, %11 row_newbcast:11 row_mask:0xf bank_mask:0xf\n\t" \
        "v_mul_f32_dpp %12, %18, %12 row_newbcast:12 row_mask:0xf bank_mask:0xf\n\t" \
        "v_mul_f32_dpp %13, %18, %13 row_newbcast:13 row_mask:0xf bank_mask:0xf\n\t" \
        "v_mul_f32_dpp %14, %18, %14 row_newbcast:14 row_mask:0xf bank_mask:0xf\n\t" \
        "v_mul_f32_dpp %15, %18, %15 row_newbcast:15 row_mask:0xf bank_mask:0xf\n\t" \
        "v_fmac_f32_dpp %0, %19, %20 row_newbcast:0 row_mask:0xf bank_mask:0xf\n\t" \
        "v_fmac_f32_dpp %1, %19, %20 row_newbcast:1 row_mask:0xf bank_mask:0xf\n\t" \
        "v_fmac_f32_dpp %2, %19, %20 row_newbcast:2 row_mask:0xf bank_mask:0xf\n\t" \
        "v_fmac_f32_dpp %3, %19, %20 row_newbcast:3 row_mask:0xf bank_mask:0xf\n\t" \
        "v_fmac_f32_dpp %4, %19, %20 row_newbcast:4 row_mask:0xf bank_mask:0xf\n\t" \
        "v_fmac_f32_dpp %5, %19, %20 row_newbcast:5 row_mask:0xf bank_mask:0xf\n\t" \
        "v_fmac_f32_dpp %6, %19, %20 row_newbcast:6 row_mask:0xf bank_mask:0xf\n\t" \
        "v_fmac_f32_dpp %7, %19, %20 row_newbcast:7 row_mask:0xf bank_mask:0xf\n\t" \
        "v_fmac_f32_dpp %8, %19, %20 row_newbcast:8 row_mask:0xf bank_mask:0xf\n\t" \
        "v_fmac_f32_dpp %9, %19, %20 row_newbcast:9 row_mask:0xf bank_mask:0xf\n\t" \
        "v_fmac_f32_dpp %10, %19, %20 row_newbcast:10 row_mask:0xf bank_mask:0xf\n\t" \
        "v_fmac_f32_dpp %11, %19, %20 row_newbcast:11 row_mask:0xf bank_mask:0xf\n\t" \
        "v_fmac_f32_dpp %12, %19, %20 row_newbcast:12 row_mask:0xf bank_mask:0xf\n\t" \
        "v_fmac_f32_dpp %13, %19, %20 row_newbcast:13 row_mask:0xf bank_mask:0xf\n\t" \
        "v_fmac_f32_dpp %14, %19, %20 row_newbcast:14 row_mask:0xf bank_mask:0xf\n\t" \
        "v_fmac_f32_dpp %15, %19, %20 row_newbcast:15 row_mask:0xf bank_mask:0xf\n\t" \
        "v_fmac_f32_dpp %0, %21, %22 row_newbcast:0 row_mask:0xf bank_mask:0xf\n\t" \
        "v_fmac_f32_dpp %1, %21, %22 row_newbcast:1 row_mask:0xf bank_mask:0xf\n\t" \
        "v_fmac_f32_dpp %2, %21, %22 row_newbcast:2 row_mask:0xf bank_mask:0xf\n\t" \
        "v_fmac_f32_dpp %3, %21, %22 row_newbcast:3 row_mask:0xf bank_mask:0xf\n\t" \
        "v_fmac_f32_dpp %4, %21, %22 row_newbcast:4 row_mask:0xf bank_mask:0xf\n\t" \
        "v_fmac_f32_dpp %5, %21, %22 row_newbcast:5 row_mask:0xf bank_mask:0xf\n\t" \
        "v_fmac_f32_dpp %6, %21, %22 row_newbcast:6 row_mask:0xf bank_mask:0xf\n\t" \
        "v_fmac_f32_dpp %7, %21, %22 row_newbcast:7 row_mask:0xf bank_mask:0xf\n\t" \
        "v_fmac_f32_dpp %8, %21, %22 row_newbcast:8 row_mask:0xf bank_mask:0xf\n\t" \
        "v_fmac_f32_dpp %9, %21, %22 row_newbcast:9 row_mask:0xf bank_mask:0xf\n\t" \
        "v_fmac_f32_dpp %10, %21, %22 row_newbcast:10 row_mask:0xf bank_mask:0xf\n\t" \
        "v_fmac_f32_dpp %11, %21, %22 row_newbcast:11 row_mask:0xf bank_mask:0xf\n\t" \
        "v_fmac_f32_dpp %12, %21, %22 row_newbcast:12 row_mask:0xf bank_mask:0xf\n\t" \
        "v_fmac_f32_dpp %13, %21, %22 row_newbcast:13 row_mask:0xf bank_mask:0xf\n\t" \
        "v_fmac_f32_dpp %14, %21, %22 row_newbcast:14 row_mask:0xf bank_mask:0xf\n\t" \
        "v_fmac_f32_dpp %15, %21, %22 row_newbcast:15 row_mask:0xf bank_mask:0xf\n\t" \
        "v_fmac_f32_dpp %16, %23, %0 row_newbcast:0 row_mask:0xf bank_mask:0xf\n\t" \
        "v_fmac_f32_dpp %17, %23, %1 row_newbcast:1 row_mask:0xf bank_mask:0xf\n\t" \
        "v_fmac_f32_dpp %16, %23, %2 row_newbcast:2 row_mask:0xf bank_mask:0xf\n\t" \
        "v_fmac_f32_dpp %17, %23, %3 row_newbcast:3 row_mask:0xf bank_mask:0xf\n\t" \
        "v_fmac_f32_dpp %16, %23, %4 row_newbcast:4 row_mask:0xf bank_mask:0xf\n\t" \
        "v_fmac_f32_dpp %17, %23, %5 row_newbcast:5 row_mask:0xf bank_mask:0xf\n\t" \
        "v_fmac_f32_dpp %16, %23, %6 row_newbcast:6 row_mask:0xf bank_mask:0xf\n\t" \
        "v_fmac_f32_dpp %17, %23, %7 row_newbcast:7 row_mask:0xf bank_mask:0xf\n\t" \
        "v_fmac_f32_dpp %16, %23, %8 row_newbcast:8 row_mask:0xf bank_mask:0xf\n\t" \
        "v_fmac_f32_dpp %17, %23, %9 row_newbcast:9 row_mask:0xf bank_mask:0xf\n\t" \
        "v_fmac_f32_dpp %16, %23, %10 row_newbcast:10 row_mask:0xf bank_mask:0xf\n\t" \
        "v_fmac_f32_dpp %17, %23, %11 row_newbcast:11 row_mask:0xf bank_mask:0xf\n\t" \
        "v_fmac_f32_dpp %16, %23, %12 row_newbcast:12 row_mask:0xf bank_mask:0xf\n\t" \
        "v_fmac_f32_dpp %17, %23, %13 row_newbcast:13 row_mask:0xf bank_mask:0xf\n\t" \
        "v_fmac_f32_dpp %16, %23, %14 row_newbcast:14 row_mask:0xf bank_mask:0xf\n\t" \
        "v_fmac_f32_dpp %17, %23, %15 row_newbcast:15 row_mask:0xf bank_mask:0xf\n\t" \
        : "+v"(S[(B)+0]), "+v"(S[(B)+1]), "+v"(S[(B)+2]), "+v"(S[(B)+3]), "+v"(S[(B)+4]), "+v"(S[(B)+5]), "+v"(S[(B)+6]), "+v"(S[(B)+7]), "+v"(S[(B)+8]), "+v"(S[(B)+9]), "+v"(S[(B)+10]), "+v"(S[(B)+11]), "+v"(S[(B)+12]), "+v"(S[(B)+13]), "+v"(S[(B)+14]), "+v"(S[(B)+15]), "+v"(y0), "+v"(y1) : "v"(wv), "v"(bv), "v"(sa), "v"(kv), "v"(vv), "v"(rv))
constexpr int SCAN_D = 4;
template <int MODE>
__device__ __forceinline__ void scan_load(float (&buf)[5][4], const float* pa, const float* pw, const float* pb, const float* pk, const float* pr, size_t off) {
#pragma unroll
    for (int q = 0; q < 4; ++q) { buf[0][q] = pa[off + 16 * q]; buf[1][q] = pw[off + 16 * q]; buf[2][q] = pb[off + 16 * q];
        if (MODE >= 1) buf[3][q] = pk[off + 16 * q]; if (MODE == 2) buf[4][q] = pr[off + 16 * q]; }
}
template <int MODE>
__device__ __forceinline__ float scan_step(float (&S)[64], const float (&buf)[5][4], float v) {
    float s0 = 0.f, s1 = 0.f, s2 = 0.f, s3 = 0.f;
    SCAN_SA16(s0, s1, s2, s3, buf[0][0], S, 0); SCAN_SA16(s0, s1, s2, s3, buf[0][1], S, 16); SCAN_SA16(s0, s1, s2, s3, buf[0][2], S, 32); SCAN_SA16(s0, s1, s2, s3, buf[0][3], S, 48);
    const float sa = (s0 + s1) + (s2 + s3);
    if (MODE == 0) { SCAN_UPD16_P(S, 0, buf[1][0], buf[2][0], sa); SCAN_UPD16_P(S, 16, buf[1][1], buf[2][1], sa); SCAN_UPD16_P(S, 32, buf[1][2], buf[2][2], sa); SCAN_UPD16_P(S, 48, buf[1][3], buf[2][3], sa); return 0.f; }
    if (MODE == 1) { SCAN_UPD16_Q(S, 0, buf[1][0], buf[2][0], sa, buf[3][0], v); SCAN_UPD16_Q(S, 16, buf[1][1], buf[2][1], sa, buf[3][1], v); SCAN_UPD16_Q(S, 32, buf[1][2], buf[2][2], sa, buf[3][2], v); SCAN_UPD16_Q(S, 48, buf[1][3], buf[2][3], sa, buf[3][3], v); return 0.f; }
    float y0 = 0.f, y1 = 0.f;
    SCAN_UPD16_Y(S, 0, buf[1][0], buf[2][0], sa, buf[3][0], v, buf[4][0], y0, y1); SCAN_UPD16_Y(S, 16, buf[1][1], buf[2][1], sa, buf[3][1], v, buf[4][1], y0, y1);
    SCAN_UPD16_Y(S, 32, buf[1][2], buf[2][2], sa, buf[3][2], v, buf[4][2], y0, y1); SCAN_UPD16_Y(S, 48, buf[1][3], buf[2][3], sa, buf[3][3], v, buf[4][3], y0, y1);
    return y0 + y1;
}

constexpr int P1_D = 8, P1_SLOT = 1280;
#define PIN8(arr) asm volatile("" : "+v"(arr[0]), "+v"(arr[1]), "+v"(arr[2]), "+v"(arr[3]), "+v"(arr[4]), "+v"(arr[5]), "+v"(arr[6]), "+v"(arr[7]))
#define PIN6(arr) asm volatile("" : "+v"(arr[0]), "+v"(arr[1]), "+v"(arr[2]), "+v"(arr[3]), "+v"(arr[4]), "+v"(arr[5]))
typedef float f32x32 __attribute__((ext_vector_type(32)));
typedef float f32x16 __attribute__((ext_vector_type(16)));
#define P1_RS2(s0, s1) asm volatile("s_nop 1\n\tv_permlane32_swap_b32 %0, %1\n\tv_add_f32 %0, %0, %1\n\ts_nop 4" : "+v"(s0), "+v"(s1))
__device__ __forceinline__ void p6_item(unsigned char* ws, const float* dout, LAS unsigned char* ring, int bh, int seg, int lane) {
    asm volatile("" : "+v"(lane));
    const float* Vi = dout; const float* Ai = dout + (size_t)M * DR;
    const int b = bh >> 5, h = bh & 31;
    const size_t base = ((size_t)b * T + (size_t)seg * SEGLEN) * DR + h * HD;
    const float* gsrc = (lane < 16 ? Ai : lane < 32 ? (const float*)(ws + WS_BV) : lane < 48 ? (const float*)(ws + WS_KK) : (const float*)(ws + WS_R)) + base + (lane & 15) * 4;
    const bf16* vsrc = (const bf16*)Vi + ((size_t)bh * T + (size_t)seg * SEGLEN) * 64 + lane * 8;        const float* cesrc = (const float*)(ws + WS_CEND) + ((size_t)b * (T / 64) + (size_t)seg * (SEGLEN / 64)) * DR + h * HD + lane;
    const size_t ibase = (size_t)(bh * NSEG + seg) * (SEGLEN * 64);
    unsigned* pqo = (unsigned*)(ws + WS_PQ) + ibase + lane;
    const int c = lane & 31, hh = lane >> 5;
    f32x32 SP[2]; f32x16 SQ[2][2];
#pragma unroll
    for (int jb = 0; jb < 2; ++jb)
#pragma unroll
        for (int x = 0; x < 32; ++x) { const int ib = x >> 4, q = (x >> 2) & 3, e2 = x & 3; SP[jb][x] = (32 * jb + 8 * q + 4 * hh + e2 == 32 * ib + c) ? 1.f : 0.f; SQ[jb][ib][x & 15] = 0.f; }
    const unsigned rbase = (unsigned)(size_t)ring, vaddr = rbase + (unsigned)lane * 2u, caddr = rbase + (unsigned)c * 4u, haddr = rbase + (unsigned)hh * 16u, kaddr = caddr + (unsigned)hh * 256u;
    asm volatile("s_waitcnt vmcnt(0)" ::: "memory");
    __builtin_amdgcn_global_load_lds((const unsigned*)cesrc, (LAS unsigned*)(ring + P1_D * P1_SLOT), 4, 0, 0);
    constexpr int VBASE = P1_D * P1_SLOT + 256;
    __builtin_amdgcn_global_load_lds((const unsigned*)vsrc, (LAS unsigned*)(ring + VBASE), 16, 0, 0);
    __builtin_amdgcn_global_load_lds((const unsigned*)(vsrc + 8 * 64), (LAS unsigned*)(ring + VBASE + 1024), 16, 0, 0);
#pragma unroll
    for (int d = 0; d < P1_D; ++d) __builtin_amdgcn_global_load_lds((const unsigned*)(gsrc + (size_t)d * DR), (LAS unsigned*)(ring + d * P1_SLOT), 16, 0, 0);
    f32x4 X[8]; float bb[2], kk[2]; unsigned vv;
#define LDX(SL, VOFF) asm volatile("ds_read_b128 %0, %8 offset:%9\n\tds_read_b128 %1, %8 offset:%10\n\tds_read_b128 %2, %8 offset:%11\n\tds_read_b128 %3, %8 offset:%12\n\t" \
                                   "ds_read_b128 %4, %8 offset:%13\n\tds_read_b128 %5, %8 offset:%14\n\tds_read_b128 %6, %8 offset:%15\n\tds_read_b128 %7, %8 offset:%16" \
        : "=&v"(X[0]), "=&v"(X[1]), "=&v"(X[2]), "=&v"(X[3]), "=&v"(X[4]), "=&v"(X[5]), "=&v"(X[6]), "=&v"(X[7]) : "v"(haddr), \
          "n"((SL) * P1_SLOT + (VOFF)), "n"((SL) * P1_SLOT + (VOFF) + 32), "n"((SL) * P1_SLOT + (VOFF) + 64), "n"((SL) * P1_SLOT + (VOFF) + 96), \
          "n"((SL) * P1_SLOT + (VOFF) + 128), "n"((SL) * P1_SLOT + (VOFF) + 160), "n"((SL) * P1_SLOT + (VOFF) + 192), "n"((SL) * P1_SLOT + (VOFF) + 224))
#define LDBKV(SL, VA) asm volatile("ds_read_b32 %0, %5 offset:%8\n\tds_read_b32 %1, %5 offset:%9\n\tds_read_b32 %2, %6 offset:%8\n\tds_read_b32 %3, %6 offset:%9\n\tds_read_u16 %4, %7 offset:%10" \
        : "=&v"(bb[0]), "=&v"(bb[1]), "=&v"(kk[0]), "=&v"(kk[1]), "=&v"(vv) : "v"(caddr), "v"(kaddr), "v"(VA), "n"((SL) * P1_SLOT + 256), "n"((SL) * P1_SLOT + 256 + 128), "n"(VBASE + (SL) * 128))
#define WX(N) asm volatile("s_waitcnt lgkmcnt(%8)" : "+v"(X[0]), "+v"(X[1]), "+v"(X[2]), "+v"(X[3]), "+v"(X[4]), "+v"(X[5]), "+v"(X[6]), "+v"(X[7]) : "n"(N))
#define DOTS(o0, o1, u0, u1) do { f32x2 a0 = {0.f, 0.f}, a1 = a0, c0 = a0, c1 = a0; \
        _Pragma("unroll") for (int jb = 0; jb < 2; ++jb) _Pragma("unroll") for (int q = 0; q < 4; ++q) { const f32x4 xq = X[4 * jb + q]; const f32x2 lo = {xq.x, xq.y}, hi = {xq.z, xq.w}; \
            a0 = __builtin_elementwise_fma((f32x2){SP[jb][4 * q], SP[jb][4 * q + 1]}, lo, a0); a0 = __builtin_elementwise_fma((f32x2){SP[jb][4 * q + 2], SP[jb][4 * q + 3]}, hi, a0); \
            a1 = __builtin_elementwise_fma((f32x2){SP[jb][16 + 4 * q], SP[jb][16 + 4 * q + 1]}, lo, a1); a1 = __builtin_elementwise_fma((f32x2){SP[jb][16 + 4 * q + 2], SP[jb][16 + 4 * q + 3]}, hi, a1); \
            c0 = __builtin_elementwise_fma((f32x2){SQ[jb][0][4 * q], SQ[jb][0][4 * q + 1]}, lo, c0); c0 = __builtin_elementwise_fma((f32x2){SQ[jb][0][4 * q + 2], SQ[jb][0][4 * q + 3]}, hi, c0); \
            c1 = __builtin_elementwise_fma((f32x2){SQ[jb][1][4 * q], SQ[jb][1][4 * q + 1]}, lo, c1); c1 = __builtin_elementwise_fma((f32x2){SQ[jb][1][4 * q + 2], SQ[jb][1][4 * q + 3]}, hi, c1); } \
        o0 = a0.x + a0.y; o1 = a1.x + a1.y; u0 = c0.x + c0.y; u1 = c1.x + c1.y; } while (0)
    asm volatile("s_waitcnt vmcnt(%0)" :: "n"(P1_D - 1) : "memory");
    LDX(0, 0); LDBKV(0, vaddr);
    for (int t0 = 0; t0 < SEGLEN; t0 += P1_D) {
        const unsigned vh = vaddr + ((t0 & 8) ? 1024u : 0u), vhn = vaddr + ((t0 & 8) ? 0u : 1024u);
#pragma unroll
        for (int d = 0; d < P1_D; ++d) {
            constexpr int PD2 = P1_D - 2;
            constexpr int W0[8] = {6, 7, 8, 9, 10, 11, 12, 12}, W1[8] = {13, 13, 13, 13, 13, 13, 13, 12};
            if (t0 == 0) asm volatile("s_waitcnt vmcnt(%0)" :: "n"(W0[d]) : "memory");
            else asm volatile("s_waitcnt vmcnt(%0)" :: "n"(W1[d]) : "memory");
            const int sn = (d + 1) % P1_D;
            asm volatile("s_waitcnt lgkmcnt(0)" : "+v"(X[0]), "+v"(X[1]), "+v"(X[2]), "+v"(X[3]), "+v"(X[4]), "+v"(X[5]), "+v"(X[6]), "+v"(X[7]), "+v"(bb[0]), "+v"(bb[1]), "+v"(kk[0]), "+v"(kk[1]), "+v"(vv));
            float sP0, sP1, sQ0, sQ1;
            DOTS(sP0, sP1, sQ0, sQ1);
            asm volatile("" : "+v"(sP0), "+v"(sP1), "+v"(sQ0), "+v"(sQ1));
            LDX(d, 768);
            P1_RS2(sP0, sP1); P1_RS2(sQ0, sQ1);
            float bq0 = sQ0, bq1 = __builtin_bit_cast(float, vv << 16);
            asm volatile("s_nop 1\n\tv_permlane32_swap_b32 %0, %1\n\ts_nop 4" : "+v"(bq0), "+v"(bq1));
#pragma unroll
            for (int jb = 0; jb < 2; ++jb) {
                SP[jb] = __builtin_amdgcn_mfma_f32_32x32x1f32(bb[jb], sP0, SP[jb], 0, 0, 0);
                SQ[jb][0] = __builtin_amdgcn_mfma_f32_32x32x2f32(kk[jb], bq0, SQ[jb][0], 0, 0, 0);
                SQ[jb][1] = __builtin_amdgcn_mfma_f32_32x32x2f32(kk[jb], bq1, SQ[jb][1], 0, 0, 0); }
            WX(0);
            float dP0, dP1, dQ0, dQ1;
            DOTS(dP0, dP1, dQ0, dQ1);
            asm volatile("" : "+v"(dP0), "+v"(dP1), "+v"(dQ0), "+v"(dQ1));
            LDX(sn, 0); if (d < P1_D - 1) LDBKV(sn, vh); else LDBKV(sn, vhn);
            P1_RS2(dP0, dP1); P1_RS2(dQ0, dQ1);
            const int tn = (t0 + d + P1_D < SEGLEN) ? t0 + d + P1_D : SEGLEN - 1;
            { unsigned w; asm volatile("v_cvt_pk_bf16_f32 %0, %1, %2" : "=v"(w) : "v"(dP0), "v"(dQ0)); pqo[(size_t)(t0 + d) * 64] = w; }
            if (d == P1_D - 1 && ((t0 + d) & 63) == 63) {
                f32x4 cq[8];
                asm volatile("s_waitcnt lgkmcnt(0)" : "+v"(X[0]), "+v"(X[1]), "+v"(X[2]), "+v"(X[3]), "+v"(X[4]), "+v"(X[5]), "+v"(X[6]), "+v"(X[7]), "+v"(bb[0]), "+v"(bb[1]), "+v"(kk[0]), "+v"(kk[1]), "+v"(vv));
#pragma unroll
                for (int x = 0; x < 8; ++x) asm volatile("ds_read_b128 %0, %1 offset:%2" : "=v"(cq[x]) : "v"(haddr), "n"(P1_D * P1_SLOT + 32 * x));
                asm volatile("s_waitcnt lgkmcnt(0)" : "+v"(cq[0]), "+v"(cq[1]), "+v"(cq[2]), "+v"(cq[3]), "+v"(cq[4]), "+v"(cq[5]), "+v"(cq[6]), "+v"(cq[7]));
#pragma unroll
                for (int jb = 0; jb < 2; ++jb)
#pragma unroll
                    for (int x = 0; x < 32; ++x) { const int q = (x >> 2) & 3, e2 = x & 3; const float cv = cq[4 * jb + q][e2]; SP[jb][x] *= cv; SQ[jb][x >> 4][x & 15] *= cv; }
                if (t0 + d + 1 < SEGLEN) __builtin_amdgcn_global_load_lds((const unsigned*)(cesrc + (size_t)((t0 + d + 1) >> 6) * DR), (LAS unsigned*)(ring + P1_D * P1_SLOT), 4, 0, 0);
            }
            __builtin_amdgcn_global_load_lds((const unsigned*)(gsrc + (size_t)tn * DR), (LAS unsigned*)(ring + d * P1_SLOT), 16, 0, 0);
            if (d == P1_D - 1) { const int tv = (t0 + d + 9 <= SEGLEN - 8) ? t0 + d + 9 : SEGLEN - 8;
                __builtin_amdgcn_global_load_lds((const unsigned*)(vsrc + (size_t)tv * 64), (LAS unsigned*)(ring + VBASE + ((t0 & 8) ? 1024 : 0)), 16, 0, 0); }
        }
    }
    asm volatile("s_waitcnt lgkmcnt(0)" : "+v"(X[0]), "+v"(X[1]), "+v"(X[2]), "+v"(X[3]), "+v"(X[4]), "+v"(X[5]), "+v"(X[6]), "+v"(X[7]), "+v"(bb[0]), "+v"(bb[1]), "+v"(kk[0]), "+v"(kk[1]), "+v"(vv));
#undef LDX
#undef LDBKV
#undef WX
#undef DOTS
    int lane2 = lane; asm volatile("" : "+v"(lane2));
    const int c2 = lane2 & 31, h2 = lane2 >> 5;
    float* dp = (float*)(ws + WS_PBUF) + (size_t)(bh * NSEG + seg) * 4096 + c2 * 64 + h2 * 4; float* dq = (float*)(ws + WS_QBUF) + (size_t)(bh * NSEG + seg) * 4096 + c2 * 64 + h2 * 4;
#pragma unroll
    for (int jb = 0; jb < 2; ++jb)
#pragma unroll
        for (int ib = 0; ib < 2; ++ib)
#pragma unroll
            for (int q = 0; q < 4; ++q) { const int x = 16 * ib + 4 * q;
                *(f32x4*)(dp + ib * 2048 + jb * 32 + q * 8) = (f32x4){SP[jb][x], SP[jb][x + 1], SP[jb][x + 2], SP[jb][x + 3]};
                *(f32x4*)(dq + ib * 2048 + jb * 32 + q * 8) = (f32x4){SQ[jb][ib][4 * q], SQ[jb][ib][4 * q + 1], SQ[jb][ib][4 * q + 2], SQ[jb][ib][4 * q + 3]}; }
}
__device__ __forceinline__ void p6_scan_pass1(unsigned char* ws, const float* dout, LAS unsigned char* lds, int wave, int lane) {
    LAS unsigned char* ring = lds + wave * (P1_D * P1_SLOT + 256 + 2048);
    for (int pi = blockIdx.x * NWAVES + wave; pi < 64 * NSEG; pi += gridDim.x * NWAVES) {
        const int bh = pi >> 5, seg = pi & 31;
        p6_item(ws, dout, ring, bh, seg, lane);
    }
    asm volatile("s_waitcnt vmcnt(0)" ::: "memory");
}

__device__ __forceinline__ void p7_combine(unsigned char* ws, LAS unsigned char* lds, int tid) {
    LAS float* Sl = (LAS float*)lds;
    LAS float* Pl = (LAS float*)(lds + 4160);
    const int il = tid >> 5, jq = tid & 31, pi = tid >> 3, pj = tid & 7;
    for (int it = blockIdx.x; it < 64 * 4; it += gridDim.x) {
        const int bh = it >> 2, i = (it & 3) * 16 + il;
        float S0 = 0.f, S1 = 0.f;
        for (int seg = 0; seg < NSEG; ++seg) {
            const size_t mo = ((size_t)(bh * NSEG + seg) * 64 + i) * 64 + jq * 2;
            *(f32x2*)((float*)(ws + WS_SST) + mo) = (f32x2){S0, S1};
            if (seg == NSEG - 1) break;
            const float* pp = (const float*)(ws + WS_PBUF) + ((size_t)(bh * NSEG + seg) * 64 + pi) * 64 + pj * 8;
            const f32x4 p0 = *(const f32x4*)pp, p1 = *(const f32x4*)(pp + 4); const f32x2 q = *(const f32x2*)((const float*)(ws + WS_QBUF) + mo);
            __syncthreads();
            *(LAS f32x4*)(Pl + pi * 64 + pj * 8) = p0; *(LAS f32x4*)(Pl + pi * 64 + pj * 8 + 4) = p1;
            Sl[il * 65 + jq * 2] = S0; Sl[il * 65 + jq * 2 + 1] = S1;
            __syncthreads();
            float a0 = q.x, a1 = q.y, b0 = 0.f, b1 = 0.f;
#pragma unroll 8
            for (int mm = 0; mm < 64; mm += 2) { const float s0 = Sl[il * 65 + mm], s1 = Sl[il * 65 + mm + 1]; const f32x2 pa = *(const LAS f32x2*)(Pl + mm * 64 + jq * 2), pb = *(const LAS f32x2*)(Pl + (mm + 1) * 64 + jq * 2);
                a0 += s0 * pa.x; a1 += s0 * pa.y; b0 += s1 * pb.x; b1 += s1 * pb.y; }
            S0 = a0 + b0; S1 = a1 + b1;
        }
        __syncthreads();
    }
}

__device__ __forceinline__ void p8_scan_pass3(const float* lnx_w, const float* lnx_b, unsigned char* ws, const float* dout, LAS unsigned char* sl, int gw, int NGW, int lane) {
    const float* Vi = dout;
    const bf16* G = (const bf16*)(ws + WS_G); const float* BON = (const float*)(ws + WS_BONUS); bf16* O = (bf16*)(ws + WS_OCB);
    const int n = lane & 15, g4 = (lane >> 4) * 4;
    LAS f32x4* sa = (LAS f32x4*)sl + lane;
    for (int item = gw; item < 64 * NSEG; item += NGW) {
        const int h = item & 31, seg = (item >> 5) & 31, b = item >> 10, bh = b * 32 + h;
        const size_t row0 = (size_t)b * T + (size_t)seg * SEGLEN + n;
        const size_t base = row0 * DR + h * HD + g4;
        { const float* sp = (const float*)(ws + WS_SST) + (size_t)(bh * NSEG + seg) * 4096 + g4;
#pragma unroll
          for (int mt = 0; mt < 4; ++mt)
#pragma unroll
              for (int c = 0; c < 4; ++c) sa[(mt * 4 + c) * 64] = *(const f32x4*)(sp + (16 * mt + n) * 64 + 16 * c); }
        asm volatile("" ::: "memory");
        f32x4 lw[4], lb[4];
#pragma unroll
        for (int mt = 0; mt < 4; ++mt) { lw[mt] = *(const f32x4*)(lnx_w + h * HD + 16 * mt + g4); lb[mt] = *(const f32x4*)(lnx_b + h * HD + 16 * mt + g4); }
        const size_t ibase = (size_t)(bh * NSEG + seg) * (SEGLEN * 64) + n * 64 + g4;
        const unsigned* pq = (const unsigned*)(ws + WS_PQ) + ibase; const bf16* vp = (const bf16*)Vi + ((size_t)bh * T + (size_t)seg * SEGLEN + n) * 64 + g4; const bf16* gp = G + base;
        const float* bp = BON + row0 * NH + h; bf16* op = O + row0 * D + h * HD + g4;
        v4u npq[4]; v2u nv[4]; v2u ng[4]; float nbo;
#define P9_LOAD(BLK) do { const size_t ro = (size_t)(BLK) * 16 * DR, ri = (size_t)(BLK) * 16 * 64; \
            _Pragma("unroll") for (int q = 0; q < 4; ++q) { npq[q] = __builtin_nontemporal_load((const GAS v4u*)(pq + ri + 16 * q)); \
                nv[q] = __builtin_nontemporal_load((const GAS v2u*)(vp + ri + 16 * q)); ng[q] = __builtin_nontemporal_load((const GAS v2u*)(gp + ro + 16 * q)); } \
            nbo = bp[(size_t)(BLK) * 16 * NH]; } while (0)
        P9_LOAD(0);
#pragma unroll 1
        for (int blk = 0; blk < SEGLEN / 16; ++blk) {
            f32x4 pb[4], acc[4], vv[4]; v2u gg[4];
#pragma unroll
            for (int q = 0; q < 4; ++q) { const v4u w = npq[q]; pb[q] = (f32x4){bflo(w.x), bflo(w.y), bflo(w.z), bflo(w.w)}; acc[q] = (f32x4){bfhi(w.x), bfhi(w.y), bfhi(w.z), bfhi(w.w)}; vv[q] = (f32x4){bflo(nv[q].x), bfhi(nv[q].x), bflo(nv[q].y), bfhi(nv[q].y)}; gg[q] = ng[q]; }
            const float bo = nbo;
            { const int bn = blk + 1 < SEGLEN / 16 ? blk + 1 : blk; P9_LOAD(bn); }
#pragma unroll
            for (int c = 0; c < 4; ++c) {
                f32x4 a[4];
#pragma unroll
                for (int mt = 0; mt < 4; ++mt) a[mt] = sa[(mt * 4 + c) * 64];
#pragma unroll
                for (int r = 0; r < 4; ++r)
#pragma unroll
                    for (int mt = 0; mt < 4; ++mt) acc[mt] = __builtin_amdgcn_mfma_f32_16x16x4f32(a[mt][r], pb[c][r], acc[mt], 0, 0, 0);
                if (c & 1) asm volatile("" ::: "memory");
            }
            float s1 = 0.f, s2 = 0.f;
#pragma unroll
            for (int mt = 0; mt < 4; ++mt) { s1 += (acc[mt].x + acc[mt].y) + (acc[mt].z + acc[mt].w); s2 += (acc[mt].x * acc[mt].x + acc[mt].y * acc[mt].y) + (acc[mt].z * acc[mt].z + acc[mt].w * acc[mt].w); }
            s1 += __shfl_xor(s1, 16); s2 += __shfl_xor(s2, 16); s1 += __shfl_xor(s1, 32); s2 += __shfl_xor(s2, 32);
            const float mean = s1 * (1.0f / 64.0f), var = fmaxf(s2 * (1.0f / 64.0f) - mean * mean, 0.f), rstd = __builtin_amdgcn_rsqf(var + LNX_EPS);
            bf16* orow = op + (size_t)blk * 16 * D;
#pragma unroll
            for (int mt = 0; mt < 4; ++mt) {
                const f32x4 yn = (acc[mt] - mean) * rstd * lw[mt] + lb[mt];
                const f32x4 gf = {bflo(gg[mt].x), bfhi(gg[mt].x), bflo(gg[mt].y), bfhi(gg[mt].y)};
                const f32x4 o = (yn + vv[mt] * bo) * gf;
                v2u w; w.x = pk2(o.x, o.y); w.y = pk2(o.z, o.w);
                *(GAS v2u*)(orow + 16 * mt) = w;
            }
        }
#undef P9_LOAD
    }
}

__device__ __forceinline__ void p15_act_fixup(const float* convw, unsigned char* ws, int gt, int NT) {
    const bf16* HG0 = (const bf16*)(ws + WS_HG0); const bf16* HV0 = (const bf16*)(ws + WS_HV0); const bf16* HG1 = (const bf16*)(ws + WS_HG1); bf16* ACT = (bf16*)(ws + WS_ACT);
    constexpr int NC8 = FF / 8;
    for (int e = gt; e < 256 * 2 * NC8; e += NT) {
        const int c8 = e % NC8, rr = (e / NC8) & 1, blk = e / (2 * NC8), c = c8 * 8;
        const bool first = (blk % (T / 64)) == 0;
        const v4u z = {0u, 0u, 0u, 0u};
        const v4u g0 = *(const GAS v4u*)(HG0 + ((size_t)blk * 2 + rr) * FF + c), vv = *(const GAS v4u*)(HV0 + ((size_t)blk * 2 + rr) * FF + c);
        const v4u p63 = first ? z : *(const GAS v4u*)(HG1 + ((size_t)(blk - 1) * 2 + 1) * FF + c), p62 = first ? z : *(const GAS v4u*)(HG1 + ((size_t)(blk - 1) * 2 + 0) * FF + c);
        const v4u g1 = rr ? *(const GAS v4u*)(HG0 + ((size_t)blk * 2 + 0) * FF + c) : p63;
        const v4u g2 = rr ? p63 : p62;
        const f32x4 wa0 = *(const f32x4*)(convw + c), wa1 = *(const f32x4*)(convw + c + 4), wb0 = *(const f32x4*)(convw + FF + c), wb1 = *(const f32x4*)(convw + FF + c + 4), wc0 = *(const f32x4*)(convw + 2 * FF + c), wc1 = *(const f32x4*)(convw + 2 * FF + c + 4);
        float y[8];
        y[0] = wa0.x * bflo(g2.x) + wb0.x * bflo(g1.x) + wc0.x * bflo(g0.x); y[1] = wa0.y * bfhi(g2.x) + wb0.y * bfhi(g1.x) + wc0.y * bfhi(g0.x);
        y[2] = wa0.z * bflo(g2.y) + wb0.z * bflo(g1.y) + wc0.z * bflo(g0.y); y[3] = wa0.w * bfhi(g2.y) + wb0.w * bfhi(g1.y) + wc0.w * bfhi(g0.y);
        y[4] = wa1.x * bflo(g2.z) + wb1.x * bflo(g1.z) + wc1.x * bflo(g0.z); y[5] = wa1.y * bfhi(g2.z) + wb1.y * bfhi(g1.z) + wc1.y * bfhi(g0.z);
        y[6] = wa1.z * bflo(g2.w) + wb1.z * bflo(g1.w) + wc1.z * bflo(g0.w); y[7] = wa1.w * bfhi(g2.w) + wb1.w * bfhi(g1.w) + wc1.w * bfhi(g0.w);
        const float vl[8] = {bflo(vv.x), bfhi(vv.x), bflo(vv.y), bfhi(vv.y), bflo(vv.z), bfhi(vv.z), bflo(vv.w), bfhi(vv.w)};
        float o[8];
#pragma unroll
        for (int q = 0; q < 8; ++q) o[q] = y[q] * sigm(y[q]) * vl[q];
        v4u ov; ov.x = pk2(o[0], o[1]); ov.y = pk2(o[2], o[3]); ov.z = pk2(o[4], o[5]); ov.w = pk2(o[6], o[7]);
        *(GAS v4u*)(ACT + ((size_t)blk * 64 + rr) * FF + c) = ov;
    }
}

constexpr int N_PHASES = 17;
struct Args { const float* in[26]; float* out; unsigned char* ws; int ph_lo, ph_hi, li, pad; };
__global__ void __launch_bounds__(NWAVES * 64, 2) mk_fwd(Args args) {
    extern __shared__ __attribute__((aligned(16))) unsigned char lds_raw[];
    LAS unsigned char* lds = (LAS unsigned char*)lds_raw;
    volatile LAS unsigned* MISC = (volatile LAS unsigned*)(lds + MISC_OFF);
    const int tid = threadIdx.x, lane = tid & 63, wave = __builtin_amdgcn_readfirstlane(tid >> 6);
    const int G = gridDim.x, gw = blockIdx.x * NWAVES + wave, NGW = G * NWAVES, gt = gw * 64 + lane, NT = NGW * 64;
    unsigned char* ws = args.ws; float* dout = args.out;
    gu32* ctl = (gu32*)(ws + WS_CTL);
    for (int u = tid; u < (LDS_BYTES - LDSCTL_OFF) / 4; u += NWAVES * 64) ((LAS unsigned*)(lds + LDSCTL_OFF))[u] = 0u;
    __syncthreads();
    XcdBarrier bar; bar.bar = (unsigned*)(ctl + CW_BAR) + args.li * XCD_BAR_WORDS; bar.x = 0; bar.st = nullptr;
    if (MK_N_LAUNCHES == 1) bar = xcd_barrier_post((unsigned*)(ctl + CW_BAR), MISC + 8);
    const int lo = args.ph_lo, hi = args.ph_hi;
#define IN(k) (lo <= (k) && (k) < hi)
#define SEAM(k) do { if (IN(k) && IN((k) + 1)) xcd_barrier(bar); } while (0)
    const float* MOD = (const float*)(ws + WS_MOD);

    if (IN(0)) { p0_prologue(args.in, ws, lds, gw, NGW, tid, lane, wave); }
    if (IN(0) && IN(2)) xcd_barrier(bar);
    if (IN(2)) { norm_mod_rows<false>(args.in[0], nullptr, args.in[4], MOD, 0, D, (bf16*)(ws + WS_H), lds, gw, NGW, tid, lane); }
    SEAM(2);
    if (IN(3)) {
        pg8::Gemm g{(const pg8::bf16_t*)(ws + WS_H), (const pg8::bf16_t*)(ws + WS_WIN), M, N_INP, D, 1 << 30, 0}; pg8::StaticOrder S; S.init(M, N_INP, G, (int)blockIdx.x);
        pg8::EpiProj E{(pg8::bf16_t*)(ws + WS_PS), (pg8::bf16_t*)(ws + WS_PC), (pg8::bf16_t*)(ws + WS_PG)};
        pg8::gemm_phase<pg8::EpiProj, pg8::StaticOrder, PG8_ALIGN, PG8_SP2>(lds + RING_OFF, g, S, E);
    }
    SEAM(3);
    if (IN(4)) { p3_prep(args.in[6], args.in[17], ws, gw, NGW, lane); }
    SEAM(4);
    if (IN(5)) {
        pg8::Gemm g{(const pg8::bf16_t*)(ws + WS_ALORA), (const pg8::bf16_t*)(ws + WS_WLORA), M, 3 * DR, 256, 8, (size_t)M * 256 * 2}; pg8::StaticOrder S; S.init(M, 3 * DR, G, (int)blockIdx.x);
        pg8::EpiLora E{(float*)(ws + WS_WD), (pg8::bf16_t*)(ws + WS_ICLR), (pg8::bf16_t*)(ws + WS_G), args.in[7], args.in[8]};
        pg8::gemm_phase<pg8::EpiLora, pg8::StaticOrder, PG8_ALIGN, PG8_SP2, 16>(lds + RING_OFF, g, S, E);
    }
    SEAM(5);
    if (IN(6)) { p5_scanprep(args.in[6], args.in[9], args.in[10], args.in[11], ws, dout, gw, NGW, lane); }
    SEAM(6);
    if (IN(7)) { p6_scan_pass1(ws, dout, lds, wave, lane); }
    SEAM(7);
    if (IN(8)) { p7_combine(ws, lds, tid); }
    SEAM(8);
    if (IN(9)) { p8_scan_pass3(args.in[15], args.in[16], ws, dout, lds + wave * 16384, gw, NGW, lane); }
    SEAM(9);
    if (IN(10)) {
        pg8::Gemm g{(const pg8::bf16_t*)(ws + WS_OCB), (const pg8::bf16_t*)(ws + WS_WOCAT), M, D, D, 1 << 30, 0}; pg8::StaticOrder S; S.init(M, D, G, (int)blockIdx.x);
        pg8::EpiMix E{(const pg8::bf16_t*)(ws + WS_PG), (pg8::bf16_t*)(ws + WS_MERGED)};
        pg8::gemm_phase<pg8::EpiMix, pg8::StaticOrder, PG8_ALIGN, PG8_SP2>(lds + RING_OFF, g, S, E);
    }
    if (IN(10) && IN(12)) xcd_barrier(bar);
    if (IN(12)) {
        pg8::Gemm g{(const pg8::bf16_t*)(ws + WS_MERGED), (const pg8::bf16_t*)(ws + WS_WOUT), M, D, D, 1 << 30, 0}; pg8::StaticOrder S; S.init(M, D, G, (int)blockIdx.x);
        pg8::EpiDelta E{(pg8::bf16_t*)(ws + WS_D1), MOD + 2 * D};
        pg8::gemm_phase<pg8::EpiDelta, pg8::StaticOrder, PG8_ALIGN, PG8_SP2>(lds + RING_OFF, g, S, E);
    }
    SEAM(12);
    if (IN(13)) {
        norm_mod_rows<true>(args.in[0], (const bf16*)(ws + WS_D1), args.in[21], MOD, 3 * D, 4 * D, (bf16*)(ws + WS_H2), lds, gw, NGW, tid, lane);
        LAS unsigned* scr = (LAS unsigned*)(lds + 32768 + wave * 8320);
        constexpr int I_UP = 64 * 344, I_DN = 172 * 64;
        for (int it = gw; it < I_UP + I_DN; it += NGW) {
            if (it < I_UP) { const int nb = it % 344, n0 = nb * 64, isv = n0 >= FF ? 1 : 0, c0 = n0 - isv * FF;
                transpose_item(args.in[22], NUP, D, (bf16*)(ws + WS_WUP), it / 344, nb, (c0 >> 7) * 256 + (c0 & 127) + isv * 128, scr, lane); }
            else { const int r = it - I_UP; transpose_item(args.in[24], D, FF, (bf16*)(ws + WS_WDOWN), r / 64, r % 64, (r % 64) * 64, scr, lane); }
        }
    }
    SEAM(13);
    if (IN(14)) {
        pg8::Gemm g{(const pg8::bf16_t*)(ws + WS_H2), (const pg8::bf16_t*)(ws + WS_WUP), M, NUP, D, 1 << 30, 0}; pg8::StaticOrder S; S.init(M, NUP, G, (int)blockIdx.x);
        pg8::EpiAct E{(pg8::bf16_t*)(ws + WS_ACT), args.in[23], (pg8::bf16_t*)(ws + WS_HG0), (pg8::bf16_t*)(ws + WS_HV0), (pg8::bf16_t*)(ws + WS_HG1)};
        pg8::gemm_phase<pg8::EpiAct, pg8::StaticOrder, PG8_ALIGN, PG8_SP2>(lds + RING_OFF, g, S, E);
    }
    SEAM(14);
    if (IN(15)) { p15_act_fixup(args.in[23], ws, gt, NT); }
    SEAM(15);
    if (IN(16)) {
        pg8::Gemm g{(const pg8::bf16_t*)(ws + WS_ACT), (const pg8::bf16_t*)(ws + WS_WDOWN), M, D, FF, 1 << 30, 0}; pg8::StaticOrder S; S.init(M, D, G, (int)blockIdx.x);
        pg8::EpiDeltaSum E{(pg8::bf16_t*)(ws + WS_D2), MOD + 5 * D, (const pg8::bf16_t*)(ws + WS_D1)};
        pg8::gemm_phase<pg8::EpiDeltaSum, pg8::StaticOrder, PG8_ALIGN, PG8_SP2>(lds + RING_OFF, g, S, E);
    }
    SEAM(16);
    if (IN(17)) { const int l17 = fresh_lane(); final_norm_rows(args.in[0], (const bf16*)(ws + WS_D2), dout, args.in[25], lds, gw, NGW, wave * 64 + l17, l17); }
#undef IN
#undef SEAM
}

extern "C" void kernel_launch(void* const* d_in, const int* in_sizes, int n_in, void* d_out, int out_size, void* d_ws, size_t ws_size, hipStream_t stream) {
    static int grid = 0;
    if (grid == 0) {
        if (n_in != 26 || in_sizes[0] != M * D || out_size != M * D || ws_size < WS_END) { fprintf(stderr, "kernel_launch: unexpected shapes / workspace (n_in %d, ws %zu); nothing launched\n", n_in, ws_size); grid = -1; return; }
        int dev = 0, cus = 0, per_cu = 0;
        if (hipGetDevice(&dev) != hipSuccess || hipDeviceGetAttribute(&cus, hipDeviceAttributeMultiprocessorCount, dev) != hipSuccess) { grid = -1; return; }
        if (hipFuncSetAttribute((const void*)mk_fwd, hipFuncAttributeMaxDynamicSharedMemorySize, LDS_BYTES) != hipSuccess) { fprintf(stderr, "kernel_launch: hipFuncSetAttribute failed\n"); grid = -1; return; }
        if (hipOccupancyMaxActiveBlocksPerMultiprocessor(&per_cu, (const void*)mk_fwd, NWAVES * 64, LDS_BYTES) != hipSuccess || per_cu < 1)
            fprintf(stderr, "kernel_launch: note: occupancy query reports %d workgroups per CU\n", per_cu);
        (void)hipGetLastError();
        grid = cus;
    }
    if (grid < 0) return;
    if (hipMemsetAsync((char*)d_ws + WS_CTL, 0, CTL_ZERO_BYTES, stream) != hipSuccess) return;
    Args a{};
    for (int i = 0; i < 26; ++i) a.in[i] = (const float*)d_in[i];
    a.out = (float*)d_out; a.ws = (unsigned char*)d_ws;
    constexpr int NPH = 18;
    if (MK_N_LAUNCHES == 1) { a.ph_lo = 0; a.ph_hi = NPH; a.li = 0; hipLaunchKernelGGL(mk_fwd, dim3(grid), dim3(NWAVES * 64), LDS_BYTES, stream, a); }
    else { static const int reps[NPH] = {PROBE_REPS};
        for (int p = 0; p < NPH; ++p) for (int r = 0; r < reps[p]; ++r) { a.ph_lo = p; a.ph_hi = p + 1; a.li = 0; hipLaunchKernelGGL(mk_fwd, dim3(grid), dim3(NWAVES * 64), LDS_BYTES, stream, a); } }
    const hipError_t le = hipPeekAtLastError();
    if (le != hipSuccess) fprintf(stderr, "kernel_launch: launch failed: %s\n", hipGetErrorName(le));
}
```
